# Optimizing an MI355X kernel written in HIP

```python
import math
import jax
import jax.numpy as jnp
from jax import lax
import numpy as np


D_MODEL = 1024
BATCH = 8
SEQ = 4096
DEPTH = 2

HEAD_DIM = 64
ROPE_THETA = 10000.0
NORM_EPS = 1e-6
QBLK = 128

DSW_GROUPS = ((128, 1), (512, 4), (2048, 16))
DSW_HEADS_PER_GROUP = 4
DSW_HEADS = DSW_HEADS_PER_GROUP * len(DSW_GROUPS)
DSW_BLK = 128

MLA_HEADS = (3 * D_MODEL) // (4 * HEAD_DIM)
MLA_Q_RANK = D_MODEL // 4
MLA_KV_RANK = D_MODEL // 8
MLA_NOPE = HEAD_DIM
MLA_ROPE = HEAD_DIM // 2
MLA_V = HEAD_DIM

SSM_INNER = D_MODEL
SSM_HEADDIM = 64
SSM_HEADS = SSM_INNER // SSM_HEADDIM
SSM_STATE = 128
SSM_GROUPS = 2
SSM_CONV = 4
SSM_CHUNK = 128
SSM_CONV_DIM = SSM_INNER + 2 * SSM_GROUPS * SSM_STATE

SB_HEADS = 8
SB_WIDTH = SB_HEADS * HEAD_DIM

FFN_DIM = 2816
FFN_CONV = 3

IN0 = 3 * DSW_HEADS * HEAD_DIM + MLA_Q_RANK + MLA_KV_RANK + MLA_ROPE
OUT0 = DSW_HEADS_PER_GROUP * HEAD_DIM + MLA_HEADS * MLA_V
IN1 = SSM_INNER + SSM_CONV_DIM + SSM_HEADS + 3 * SB_WIDTH
OUT1 = SSM_INNER + SB_WIDTH

kernel_name = 'hybrid_dilated_mla_ssd_stickbreak'


def rmsnorm(x, g):
    xf = x.astype(jnp.float32)
    y = xf * lax.rsqrt(jnp.mean(xf * xf, axis=-1, keepdims=True) + NORM_EPS)
    return (y * g.astype(jnp.float32)).astype(x.dtype)


def group_rmsnorm(x, g, groups):
    shp = x.shape
    xf = x.astype(jnp.float32).reshape(shp[:-1] + (groups, shp[-1] // groups))
    y = xf * lax.rsqrt(jnp.mean(xf * xf, axis=-1, keepdims=True) + NORM_EPS)
    return y.reshape(shp) * g.astype(jnp.float32)


def rope(x, positions):
    d = x.shape[-1]
    half = d // 2
    inv_freq = 1.0 / (ROPE_THETA ** (jnp.arange(half, dtype=jnp.float32) * (2.0 / d)))
    ang = positions.astype(jnp.float32)[..., None] * inv_freq
    cos = jnp.cos(ang)[:, :, None, :]
    sin = jnp.sin(ang)[:, :, None, :]
    xf = x.astype(jnp.float32)
    x1, x2 = xf[..., :half], xf[..., half:]
    return jnp.concatenate([x1 * cos - x2 * sin, x2 * cos + x1 * sin], axis=-1).astype(x.dtype)


def causal_dwconv(x, w, b):
    k = w.shape[0]
    s = x.shape[1]
    xp = jnp.pad(x, ((0, 0), (k - 1, 0), (0, 0)))
    y = b
    for j in range(k):
        y = y + xp[:, j:j + s, :] * w[j]
    return y


def dilated_window_attention(q, k, v, window, dilation):
    bsz, s, h, dh = q.shape
    span = window // dilation
    lsub = s // dilation
    nb = -(-lsub // DSW_BLK)
    lp = nb * DSW_BLK

    def to_blocks(t):
        t = t.reshape(bsz, lsub, dilation, h, dh)
        t = jnp.pad(t, ((0, 0), (0, lp - lsub), (0, 0), (0, 0), (0, 0)))
        return t.reshape(bsz, nb, DSW_BLK, dilation, h, dh)

    def with_prev(t):
        prev = jnp.pad(t, ((0, 0), (1, 0), (0, 0), (0, 0), (0, 0), (0, 0)))[:, :-1]
        return jnp.concatenate([prev, t], axis=2)

    qb, kb, vb = to_blocks(q), to_blocks(k), to_blocks(v)
    kk, vv = with_prev(kb), with_prev(vb)
    scores = jnp.einsum('bnqrhd,bnkrhd->bnqrhk', qb, kk).astype(jnp.float32) * (dh ** -0.5)
    qi = jnp.arange(DSW_BLK)[:, None]
    kj = jnp.arange(2 * DSW_BLK)[None, :]
    rel = qi + DSW_BLK - kj
    key_sub = jnp.arange(nb)[:, None, None] * DSW_BLK + kj[None] - DSW_BLK
    valid = (rel >= 0) & (rel <= span) & (key_sub >= 0)
    scores = jnp.where(valid[None, :, :, None, None, :], scores, -jnp.inf)
    m = jnp.max(scores, axis=-1, keepdims=True)
    p = jnp.exp(scores - m)
    l = jnp.sum(p, axis=-1, keepdims=True)
    out = jnp.einsum('bnqrhk,bnkrhd->bnqrhd', (p / l).astype(v.dtype), vv)
    lse = (m + jnp.log(l))[..., 0]
    out = out.reshape(bsz, lp, dilation, h, dh)[:, :lsub].reshape(bsz, s, h, dh)
    lse = lse.reshape(bsz, lp, dilation, h)[:, :lsub].reshape(bsz, s, h)
    return out, lse


def causal_softmax_attention(q, k, v, scale):
    bsz, s, h, dq = q.shape
    nb = s // QBLK
    qb = q.reshape(bsz, nb, QBLK, h, dq).swapaxes(0, 1)
    key_idx = jnp.arange(s)

    def one_block(args):
        q_blk, i = args
        scores = jnp.einsum('bqhd,bkhd->bhqk', q_blk, k).astype(jnp.float32) * scale
        q_idx = i * QBLK + jnp.arange(QBLK)
        causal = key_idx[None, :] <= q_idx[:, None]
        probs = jax.nn.softmax(jnp.where(causal, scores, -jnp.inf), axis=-1)
        return jnp.einsum('bhqk,bkhd->bqhd', probs.astype(v.dtype), v)

    out = lax.map(one_block, (qb, jnp.arange(nb)))
    return out.swapaxes(0, 1).reshape(bsz, s, h, v.shape[-1])


def stick_breaking_attention(q, k, v):
    bsz, s, h, dh = q.shape
    nb = s // QBLK
    qb = q.reshape(bsz, nb, QBLK, h, dh).swapaxes(0, 1)
    key_idx = jnp.arange(s)

    def one_block(args):
        q_blk, i = args
        z = jnp.einsum('bqhd,bkhd->bhqk', q_blk, k).astype(jnp.float32) * (dh ** -0.5)
        q_idx = i * QBLK + jnp.arange(QBLK)
        strict = key_idx[None, :] < q_idx[:, None]
        log_stay = jnp.where(strict, jax.nn.log_sigmoid(-z), 0.0)
        after = lax.cumsum(log_stay, axis=3, reverse=True) - log_stay
        log_w = jnp.where(strict, jax.nn.log_sigmoid(z) + after, -jnp.inf)
        return jnp.einsum('bhqk,bkhd->bqhd', jnp.exp(log_w).astype(v.dtype), v)

    out = lax.map(one_block, (qb, jnp.arange(nb)))
    return out.swapaxes(0, 1).reshape(bsz, s, h, dh)


def ssd_chunked(x, dt, a, b_mat, c_mat):
    bsz, s, nh, p = x.shape
    g, n = b_mat.shape[2], b_mat.shape[3]
    hg = nh // g
    cl = SSM_CHUNK
    nc = s // cl
    f32 = jnp.float32
    xdt = (x.astype(f32) * dt[..., None]).reshape(bsz, nc, cl, g, hg, p)
    da = (dt * a).reshape(bsz, nc, cl, g, hg)
    bc = b_mat.astype(f32).reshape(bsz, nc, cl, g, n)
    cc = c_mat.astype(f32).reshape(bsz, nc, cl, g, n)
    cs = jnp.cumsum(da, axis=2)
    causal = jnp.tril(jnp.ones((cl, cl), dtype=bool))
    seg = cs[:, :, :, None] - cs[:, :, None, :]
    decay = jnp.exp(jnp.where(causal[None, None, :, :, None, None], seg, -jnp.inf))
    cb = jnp.einsum('bclgn,bcsgn->bclsg', cc, bc)
    y_diag = jnp.einsum('bclsgh,bcsghp->bclghp', cb[..., None] * decay, xdt)
    decay_end = jnp.exp(cs[:, :, -1:] - cs)
    states = jnp.einsum('bclgn,bclgh,bclghp->bcghpn', bc, decay_end, xdt)
    chunk_decay = jnp.exp(cs[:, :, -1])

    def step(hstate, inp):
        st, dec = inp
        return hstate * dec[..., None, None] + st, hstate

    h0 = jnp.zeros((bsz, g, hg, p, n), f32)
    _, prev = lax.scan(step, h0, (jnp.moveaxis(states, 1, 0), jnp.moveaxis(chunk_decay, 1, 0)))
    prev = jnp.moveaxis(prev, 0, 1)
    y_off = jnp.einsum('bclgn,bcghpn,bclgh->bclghp', cc, prev, jnp.exp(cs))
    return (y_diag + y_off).reshape(bsz, s, nh, p)


def even_mixer(h, positions, w_in, q_norm, w_uq, kv_norm, w_ukv, w_out):
    bsz, s, _ = h.shape
    proj = h @ w_in
    nd = DSW_HEADS * HEAD_DIM
    q = proj[..., :nd].reshape(bsz, s, DSW_HEADS, HEAD_DIM)
    k = proj[..., nd:2 * nd].reshape(bsz, s, DSW_HEADS, HEAD_DIM)
    v = proj[..., 2 * nd:3 * nd].reshape(bsz, s, DSW_HEADS, HEAD_DIM)
    o = 3 * nd
    c_q = proj[..., o:o + MLA_Q_RANK]
    o += MLA_Q_RANK
    c_kv = proj[..., o:o + MLA_KV_RANK]
    o += MLA_KV_RANK
    k_pe = proj[..., o:o + MLA_ROPE]

    q = rope(q, positions)
    k = rope(k, positions)
    outs, lses = [], []
    for gi, (window, dilation) in enumerate(DSW_GROUPS):
        sl = slice(gi * DSW_HEADS_PER_GROUP, (gi + 1) * DSW_HEADS_PER_GROUP)
        og, lg = dilated_window_attention(q[:, :, sl], k[:, :, sl], v[:, :, sl], window, dilation)
        outs.append(og)
        lses.append(lg)
    wts = jax.nn.softmax(jnp.stack(lses, axis=0), axis=0)
    y_a = jnp.sum(wts[..., None] * jnp.stack(outs, axis=0).astype(jnp.float32), axis=0).astype(h.dtype)

    qm = (rmsnorm(c_q, q_norm) @ w_uq).reshape(bsz, s, MLA_HEADS, MLA_NOPE + MLA_ROPE)
    q_nope, q_pe = qm[..., :MLA_NOPE], rope(qm[..., MLA_NOPE:], positions)
    kv = (rmsnorm(c_kv, kv_norm) @ w_ukv).reshape(bsz, s, MLA_HEADS, MLA_NOPE + MLA_V)
    k_nope, v_m = kv[..., :MLA_NOPE], kv[..., MLA_NOPE:]
    k_pe = rope(k_pe[:, :, None, :], positions)
    q_full = jnp.concatenate([q_nope, q_pe], axis=-1)
    k_full = jnp.concatenate([k_nope, jnp.broadcast_to(k_pe, (bsz, s, MLA_HEADS, MLA_ROPE))], axis=-1)
    y_b = causal_softmax_attention(q_full, k_full, v_m, (MLA_NOPE + MLA_ROPE) ** -0.5)

    y = jnp.concatenate([y_a.reshape(bsz, s, -1), y_b.reshape(bsz, s, -1)], axis=-1)
    return y @ w_out


def odd_mixer(h, w_in, conv_w, conv_b, dt_bias, a_log, d_skip, ssm_norm, w_out):
    bsz, s, _ = h.shape
    proj = h @ w_in
    z = proj[..., :SSM_INNER]
    o = SSM_INNER
    xbc = proj[..., o:o + SSM_CONV_DIM]
    o += SSM_CONV_DIM
    dt_raw = proj[..., o:o + SSM_HEADS]
    o += SSM_HEADS
    qkv = proj[..., o:]

    xbc = jax.nn.silu(causal_dwconv(xbc, conv_w, conv_b))
    gn = SSM_GROUPS * SSM_STATE
    xs = xbc[..., :SSM_INNER].reshape(bsz, s, SSM_HEADS, SSM_HEADDIM)
    bm = xbc[..., SSM_INNER:SSM_INNER + gn].reshape(bsz, s, SSM_GROUPS, SSM_STATE)
    cm = xbc[..., SSM_INNER + gn:].reshape(bsz, s, SSM_GROUPS, SSM_STATE)
    dt = jax.nn.softplus(dt_raw.astype(jnp.float32) + dt_bias.astype(jnp.float32))
    a = -jnp.exp(a_log.astype(jnp.float32))
    y = ssd_chunked(xs, dt, a, bm, cm)
    y = y + xs.astype(jnp.float32) * d_skip.astype(jnp.float32)[:, None]
    y = y.reshape(bsz, s, SSM_INNER) * jax.nn.silu(z.astype(jnp.float32))
    y_c = group_rmsnorm(y, ssm_norm, SSM_GROUPS).astype(h.dtype)

    q = qkv[..., :SB_WIDTH].reshape(bsz, s, SB_HEADS, HEAD_DIM)
    k = qkv[..., SB_WIDTH:2 * SB_WIDTH].reshape(bsz, s, SB_HEADS, HEAD_DIM)
    v = qkv[..., 2 * SB_WIDTH:].reshape(bsz, s, SB_HEADS, HEAD_DIM)
    y_d = stick_breaking_attention(q, k, v).reshape(bsz, s, SB_WIDTH)

    return jnp.concatenate([y_c, y_d], axis=-1) @ w_out


def conv_ffn(h, w_gate, w_up, conv_w, conv_b, w_down):
    gate = causal_dwconv(h @ w_gate, conv_w, conv_b)
    return (jax.nn.silu(gate) * (h @ w_up)) @ w_down


def setup_inputs(seed: int = 0) -> dict:
    key = jax.random.key(seed)
    ks = iter(jax.random.split(key, 32))
    f32 = jnp.float32

    def dense(fi, fo):
        return jax.random.normal(next(ks), (fi, fo), f32) * fi ** -0.5

    def gain(n):
        return 1.0 + 0.02 * jax.random.normal(next(ks), (n,), f32)

    def bias(n):
        return 0.02 * jax.random.normal(next(ks), (n,), f32)

    def dwconv(kw, c):
        return jax.random.normal(next(ks), (kw, c), f32) * kw ** -0.5

    def dt_bias_init(n):
        dt = jnp.exp(jax.random.uniform(next(ks), (n,), f32, math.log(1e-3), math.log(1e-1)))
        return dt + jnp.log(-jnp.expm1(-dt))

    def a_log_init(n):
        return jnp.log(jax.random.uniform(next(ks), (n,), f32, 1.0, 16.0))

    x = jax.random.normal(next(ks), (BATCH, SEQ, D_MODEL), f32)
    offset = jax.random.randint(next(ks), (BATCH, 1), 0, 1024, dtype=jnp.int32)
    positions = jnp.arange(SEQ, dtype=jnp.int32)[None, :] + offset
    return {
        'x': x,
        'positions': positions,
        'l0_norm_mix': gain(D_MODEL),
        'l0_w_in': dense(D_MODEL, IN0),
        'l0_mla_q_norm': gain(MLA_Q_RANK),
        'l0_mla_w_uq': dense(MLA_Q_RANK, MLA_HEADS * (MLA_NOPE + MLA_ROPE)),
        'l0_mla_kv_norm': gain(MLA_KV_RANK),
        'l0_mla_w_ukv': dense(MLA_KV_RANK, MLA_HEADS * (MLA_NOPE + MLA_V)),
        'l0_w_out': dense(OUT0, D_MODEL),
        'l0_norm_ffn': gain(D_MODEL),
        'l0_ffn_w_gate': dense(D_MODEL, FFN_DIM),
        'l0_ffn_w_up': dense(D_MODEL, FFN_DIM),
        'l0_ffn_conv_w': dwconv(FFN_CONV, FFN_DIM),
        'l0_ffn_conv_b': bias(FFN_DIM),
        'l0_ffn_w_down': dense(FFN_DIM, D_MODEL),
        'l1_norm_mix': gain(D_MODEL),
        'l1_w_in': dense(D_MODEL, IN1),
        'l1_ssm_conv_w': dwconv(SSM_CONV, SSM_CONV_DIM),
        'l1_ssm_conv_b': bias(SSM_CONV_DIM),
        'l1_ssm_dt_bias': dt_bias_init(SSM_HEADS),
        'l1_ssm_a_log': a_log_init(SSM_HEADS),
        'l1_ssm_d': gain(SSM_HEADS),
        'l1_ssm_norm': gain(SSM_INNER),
        'l1_w_out': dense(OUT1, D_MODEL),
        'l1_norm_ffn': gain(D_MODEL),
        'l1_ffn_w_gate': dense(D_MODEL, FFN_DIM),
        'l1_ffn_w_up': dense(D_MODEL, FFN_DIM),
        'l1_ffn_conv_w': dwconv(FFN_CONV, FFN_DIM),
        'l1_ffn_conv_b': bias(FFN_DIM),
        'l1_ffn_w_down': dense(FFN_DIM, D_MODEL),
        'final_norm': gain(D_MODEL),
    }


def reference(x, positions,
              l0_norm_mix, l0_w_in, l0_mla_q_norm, l0_mla_w_uq, l0_mla_kv_norm, l0_mla_w_ukv, l0_w_out,
              l0_norm_ffn, l0_ffn_w_gate, l0_ffn_w_up, l0_ffn_conv_w, l0_ffn_conv_b, l0_ffn_w_down,
              l1_norm_mix, l1_w_in, l1_ssm_conv_w, l1_ssm_conv_b, l1_ssm_dt_bias, l1_ssm_a_log, l1_ssm_d,
              l1_ssm_norm, l1_w_out,
              l1_norm_ffn, l1_ffn_w_gate, l1_ffn_w_up, l1_ffn_conv_w, l1_ffn_conv_b, l1_ffn_w_down,
              final_norm):
    mix_norms = [l0_norm_mix, l1_norm_mix]
    mixers = [
        (l0_w_in, l0_mla_q_norm, l0_mla_w_uq, l0_mla_kv_norm, l0_mla_w_ukv, l0_w_out),
        (l1_w_in, l1_ssm_conv_w, l1_ssm_conv_b, l1_ssm_dt_bias, l1_ssm_a_log, l1_ssm_d, l1_ssm_norm, l1_w_out),
    ]
    ffn_norms = [l0_norm_ffn, l1_norm_ffn]
    ffns = [
        (l0_ffn_w_gate, l0_ffn_w_up, l0_ffn_conv_w, l0_ffn_conv_b, l0_ffn_w_down),
        (l1_ffn_w_gate, l1_ffn_w_up, l1_ffn_conv_w, l1_ffn_conv_b, l1_ffn_w_down),
    ]
    for i in range(DEPTH):
        h = rmsnorm(x, mix_norms[i])
        if i % 2 == 0:
            x = x + even_mixer(h, positions, *mixers[i])
        else:
            x = x + odd_mixer(h, *mixers[i])
        x = x + conv_ffn(rmsnorm(x, ffn_norms[i]), *ffns[i])
    return rmsnorm(x, final_norm)
```

```cpp
#include <hip/hip_runtime.h>
#include <hip/hip_bf16.h>
#include <hip/hip_cooperative_groups.h>
#include <cstdio>
namespace cg = cooperative_groups;

typedef unsigned short u16;
typedef unsigned int u32;
using bf16x8 = __attribute__((ext_vector_type(8))) short;
using f32x16 = __attribute__((ext_vector_type(16))) float;
#define MFMA32(a, b, c) __builtin_amdgcn_mfma_f32_32x32x16_bf16((a), (b), (c), 0, 0, 0)
#define DI __device__ __forceinline__

constexpr int T_ = 32768;
constexpr int SEQ_ = 4096;
constexpr float EPS_ = 1e-6f;
constexpr float LOG2E_ = 1.4426950408889634f;
constexpr float LN2_ = 0.6931471805599453f;

constexpr size_t SZ_WIN0 = 2816ull * 1024 * 2;
constexpr size_t SZ_WUQ = 1280ull * 256 * 2;
constexpr size_t SZ_WUKV = 1536ull * 128 * 2;
constexpr size_t SZ_WOUT0 = 1024ull * 1024 * 2;
constexpr size_t SZ_WGU = 5632ull * 1024 * 2;
constexpr size_t SZ_WDN = 1024ull * 2816 * 2;
constexpr size_t SZ_WIN1 = 4352ull * 1024 * 2;
constexpr size_t SZ_WOUT1 = 1024ull * 1536 * 2;
constexpr size_t O_WIN0 = 0;
constexpr size_t O_WUQ = O_WIN0 + SZ_WIN0;
constexpr size_t O_WUKV = O_WUQ + SZ_WUQ;
constexpr size_t O_WOUT0 = O_WUKV + SZ_WUKV;
constexpr size_t O_WGU0 = O_WOUT0 + SZ_WOUT0;
constexpr size_t O_WDN0 = O_WGU0 + SZ_WGU;
constexpr size_t O_WIN1 = O_WDN0 + SZ_WDN;
constexpr size_t O_WOUT1 = O_WIN1 + SZ_WIN1;
constexpr size_t O_WGU1 = O_WOUT1 + SZ_WOUT1;
constexpr size_t O_WDN1 = O_WGU1 + SZ_WGU;
constexpr size_t O_ROPE = O_WDN1 + SZ_WDN;
constexpr size_t O_HN = O_ROPE + (size_t)T_ * 32 * 8;
constexpr size_t O_R = O_HN + (size_t)T_ * 1024 * 2;
constexpr size_t R_QKV0 = 0;
constexpr size_t R_QMLA = 0;
constexpr size_t R_KMLA = R_QMLA + (size_t)T_ * 1152 * 2;
constexpr size_t R_CMLA = R_QKV0 + (size_t)T_ * 2304 * 2;
constexpr size_t R_DSWO = R_CMLA + (size_t)T_ * 416 * 2;
constexpr size_t R_LSE = R_DSWO + 3ull * T_ * 256 * 4;
constexpr size_t R_KPE = R_LSE + 3ull * T_ * 4 * 4;
constexpr size_t R_VMLA = R_KPE + (size_t)T_ * 32 * 2;
constexpr size_t R_RSQ = R_VMLA + (size_t)T_ * 768 * 2;
constexpr size_t R_RSKV = R_RSQ + (size_t)T_ * 4;
constexpr size_t R_END0 = R_RSKV + (size_t)T_ * 4;
constexpr size_t R_GU = 0;
constexpr size_t R_XB0 = 200ull << 20;
constexpr size_t R_HEADG = (size_t)T_ * 2816 * 2;
constexpr size_t R_HEADU = R_HEADG + 128ull * 2 * 2816 * 4;
constexpr size_t R_TAILG = R_HEADU + 128ull * 2 * 2816 * 4;
constexpr size_t R_ENDF = R_TAILG + 128ull * 2 * 2816 * 4;
constexpr size_t R_Z = 0;
constexpr size_t R_XBCR = R_Z + (size_t)T_ * 1024 * 2;
constexpr size_t R_YCAT1 = R_XBCR;
constexpr size_t R_QKV1 = R_XBCR + (size_t)T_ * 1536 * 2;
constexpr size_t R_XBCC = R_QKV1 + (size_t)T_ * 1536 * 2;
constexpr size_t R_DT = R_XBCC + (size_t)T_ * 1536 * 2;
constexpr size_t R_DEC = R_DT + (size_t)T_ * 16 * 4;
constexpr size_t R_HEADX = R_DEC + 4096 * 4;
constexpr size_t R_TAILX = R_HEADX + 128ull * 3 * 1536 * 4;
constexpr size_t R_END1 = R_TAILX + 128ull * 3 * 1536 * 4;
constexpr size_t R_SIZE = (R_END1 > R_ENDF ? (R_END1 > R_END0 ? R_END1 : R_END0) : (R_ENDF > R_END0 ? R_ENDF : R_END0));
constexpr size_t WS_BAR = O_R + R_SIZE;
constexpr size_t WS_SS = WS_BAR + 256;
constexpr size_t WS_NEED = WS_SS + 3ull * T_ * 16;
static_assert(R_KMLA + (size_t)T_ * 768 * 2 <= R_CMLA, "mla alias overflow");
static_assert(WS_NEED <= 536870912ull, "workspace too large");
static_assert(R_XB0 >= R_DSWO && R_XB0 + (size_t)T_ * 1024 * 2 <= R_LSE, "xb0 must sit inside the (dead) dsw output buffer");

constexpr int SMEM_BYTES = 131072 + 4096;
constexpr int NTHR = 512;

struct Params {
  const void* in[31];
  float* out;
  char* ws;
};

typedef __attribute__((ext_vector_type(2))) __bf16 bf16x2_t;
typedef __attribute__((ext_vector_type(2))) float f32x2_t;
DI u32 pack2(float a, float b) {
  const f32x2_t v = {a, b};
  return __builtin_bit_cast(u32, __builtin_convertvector(v, bf16x2_t));
}
DI u32 pack2_old(float a, float b) {
  __hip_bfloat162 y = __float22bfloat162_rn(make_float2(a, b));
  return *reinterpret_cast<u32*>(&y);
}
DI u16 f2bf(float a) {
  __hip_bfloat16 y = __float2bfloat16(a);
  return *reinterpret_cast<u16*>(&y);
}
DI float bflo(u32 w) { return __uint_as_float(w << 16); }
DI float bfhi(u32 w) { return __uint_as_float(w & 0xffff0000u); }
DI float ex2(float x) { return __builtin_amdgcn_exp2f(x); }
DI float lg2(float x) { return __builtin_amdgcn_logf(x); }
DI float siluf(float v) { return v / (1.f + ex2(-v * LOG2E_)); }
DI int crow(int i, int h) { return (i & 3) + 8 * (i >> 2) + 4 * h; }
DI bf16x8 as_bf16x8(uint4 v) { return __builtin_bit_cast(bf16x8, v); }
DI void unpack8(uint4 v, float* f) {
  f[0] = bflo(v.x); f[1] = bfhi(v.x); f[2] = bflo(v.y); f[3] = bfhi(v.y);
  f[4] = bflo(v.z); f[5] = bfhi(v.z); f[6] = bflo(v.w); f[7] = bfhi(v.w);
}
DI int opaque_tid() { int t = threadIdx.x; asm volatile("" : "+v"(t)); return t; }
#define GT_ ((size_t)blockIdx.x * NTHR + opaque_tid())
#define GN_ ((size_t)gridDim.x * NTHR)
DI float wave_sum(float v) {
#pragma unroll
  for (int o = 32; o >= 1; o >>= 1) v += __shfl_xor(v, o);
  return v;
}

DI int colmap(int n, int cmode) {
  const int cb = n & ~31, u = n & 31, nb = u >> 4, fr = u & 15;
  if (cmode == 1 && n < 1536) return (n & ~63) + ((n >> 5) & 1) * 16 + fr + 32 * nb;
  if (cmode == 2 && ((cb % 96) >> 5) == 2) return n;
  return cb + 2 * fr + nb;
}
DI void cvt_weight(const float* __restrict__ W, u16* __restrict__ Wt, int K, int N, int Npad, int cmode,
                   const float* __restrict__ gain, size_t gtid, size_t gthreads) {
  const size_t items = (size_t)Npad * (K >> 3);
  for (size_t it = gtid; it < items; it += gthreads) {
    const int n = (int)(it % Npad);
    const int kc = (int)(it / Npad);
    const int lc = colmap(n, cmode);
    float v[8];
#pragma unroll
    for (int j = 0; j < 8; ++j) {
      const int k = kc * 8 + j;
      float w = (lc < N) ? W[(size_t)k * N + lc] : 0.f;
      if (gain) w *= gain[k];
      v[j] = w;
    }
    uint4 o;
    o.x = pack2(v[0], v[1]); o.y = pack2(v[2], v[3]); o.z = pack2(v[4], v[5]); o.w = pack2(v[6], v[7]);
    *reinterpret_cast<uint4*>(Wt + (size_t)n * K + kc * 8) = o;
  }
}

DI void cvt_weight_gu(const float* __restrict__ Wg, const float* __restrict__ Wu, u16* __restrict__ Wt, const float* __restrict__ gain,
                      size_t gtid, size_t gthreads) {
  const size_t items = 5632ull * 128;
  for (size_t it = gtid; it < items; it += gthreads) {
    const int n = (int)(it % 5632);
    const int kc = (int)(it / 5632);
    const int pn = n >> 8, bj = (n >> 7) & 1, wc = (n >> 5) & 3, nb = (n >> 4) & 1, fr = n & 15;
    const int ch = pn * 128 + (wc * 16 + fr) * 2 + bj;
    const float* W = nb ? Wu : Wg;
    float v[8];
#pragma unroll
    for (int j = 0; j < 8; ++j) v[j] = W[(size_t)(kc * 8 + j) * 2816 + ch] * gain[kc * 8 + j];
    uint4 o;
    o.x = pack2(v[0], v[1]); o.y = pack2(v[2], v[3]); o.z = pack2(v[4], v[5]); o.w = pack2(v[6], v[7]);
    *reinterpret_cast<uint4*>(Wt + (size_t)n * 1024 + kc * 8) = o;
  }
}

template <bool OUTF32>
DI void rmsnorm_rows(const float* src, const float* __restrict__ g, void* dst) {
  const int ot = opaque_tid();
  const int lane = ot & 63;
  const int gw = blockIdx.x * (NTHR / 64) + (ot >> 6);
  const int nw = gridDim.x * (NTHR / 64);
  constexpr int U = 4;
  float4 g4[4];
#pragma unroll
  for (int i = 0; i < 4; ++i) g4[i] = reinterpret_cast<const float4*>(g)[lane + 64 * i];
  for (int row0 = gw; row0 < T_; row0 += nw * U) {
    float4 v[U][4];
#pragma unroll
    for (int u = 0; u < U; ++u) {
      const int row = row0 + u * nw;
      const float4* s = reinterpret_cast<const float4*>(src + (size_t)(row < T_ ? row : row0) * 1024);
#pragma unroll
      for (int i = 0; i < 4; ++i) v[u][i] = s[lane + 64 * i];
    }
    asm volatile("" ::: "memory");
#pragma unroll
    for (int u = 0; u < U; ++u) {
      const int row = row0 + u * nw;
      float ss = 0.f;
#pragma unroll
      for (int i = 0; i < 4; ++i) ss += v[u][i].x * v[u][i].x + v[u][i].y * v[u][i].y + v[u][i].z * v[u][i].z + v[u][i].w * v[u][i].w;
      ss = wave_sum(ss);
      const float sc = rsqrtf(ss * (1.f / 1024.f) + EPS_);
      if (row < T_) {
#pragma unroll
        for (int i = 0; i < 4; ++i) {
          const float a = v[u][i].x * sc * g4[i].x, b = v[u][i].y * sc * g4[i].y, c = v[u][i].z * sc * g4[i].z, d = v[u][i].w * sc * g4[i].w;
          if (OUTF32) {
            reinterpret_cast<float4*>(reinterpret_cast<float*>(dst) + (size_t)row * 1024)[lane + 64 * i] = make_float4(a, b, c, d);
          } else {
            uint2 o;
            o.x = pack2(a, b); o.y = pack2(c, d);
            reinterpret_cast<uint2*>(reinterpret_cast<u16*>(dst) + (size_t)row * 1024)[lane + 64 * i] = o;
          }
        }
      }
    }
  }
}

enum { EPI_IN0 = 0, EPI_UQ, EPI_UKV, EPI_RES, EPI_GU, EPI_IN1 };
using f32x4 = __attribute__((ext_vector_type(4))) float;

struct GemmDesc {
  const u16* A; int lda;
  const u16* Bt; int K; int nN;
  const float* res; float* dst;
  const u16* res16;
  u16* xb; float* ss;
};

DI const char* uniform_ptr(const void* q) {
  const unsigned long long v = (unsigned long long)q;
  const unsigned lo = __builtin_amdgcn_readfirstlane((unsigned)v), hi = __builtin_amdgcn_readfirstlane((unsigned)(v >> 32));
  return reinterpret_cast<const char*>(((unsigned long long)hi << 32) | lo);
}
DI int lds_byte(int r, int c) {
  const int st = (r >> 4) * 2 + (c >> 5), rr = r & 15, cc = c & 31, ob = rr * 64 + cc * 2;
  return st * 1024 + (ob ^ (((ob >> 9) & 1) << 5));
}
DI void stage_rc(int b, int& Rr, int& Cc) {
  const int st = b / 1024, sb = b % 1024, swz = sb ^ (((sb >> 9) & 1) << 5);
  Rr = (st >> 1) * 16 + swz / 64;
  Cc = (st & 1) * 32 + (swz % 64) / 2;
}

template <int EPI>
DI void gemm_store(const Params& p, const GemmDesc& d, int row, int cb, int fr, float v0, float v1, float2 cs, float s) {
  char* R = p.ws + O_R;
  if (EPI == EPI_IN0) {
    u16* qkv = reinterpret_cast<u16*>(R + R_QKV0);
    if (cb < 1536) {
      const int dd = ((cb >> 5) & 1) * 16 + fr;
      u16* o = qkv + (size_t)row * 2304 + (cb & ~63) + dd;
      o[0] = f2bf(v0 * cs.x - v1 * cs.y);
      o[32] = f2bf(v1 * cs.x + v0 * cs.y);
    } else {
      const int c0 = cb + 2 * fr;
      if (c0 < 2304) *reinterpret_cast<u32*>(qkv + (size_t)row * 2304 + c0) = pack2_old(v0, v1);
      else if (c0 < 2720) *reinterpret_cast<u32*>(reinterpret_cast<u16*>(R + R_CMLA) + (size_t)row * 416 + (c0 - 2304)) = pack2_old(v0, v1);
    }
  } else if (EPI == EPI_UQ) {
    if (cb < 1152) {
      u16* qm = reinterpret_cast<u16*>(R + R_QMLA);
      v0 *= s; v1 *= s;
      if (((cb % 96) >> 5) == 2) {
        qm[(size_t)row * 1152 + cb + fr] = f2bf(v0 * cs.x - v1 * cs.y);
        qm[(size_t)row * 1152 + cb + 16 + fr] = f2bf(v1 * cs.x + v0 * cs.y);
      } else {
        *reinterpret_cast<u32*>(qm + (size_t)row * 1152 + cb + 2 * fr) = pack2_old(v0, v1);
      }
    }
  } else if (EPI == EPI_UKV) {
    const int c0 = cb + 2 * fr, head = c0 >> 7, w = c0 & 127;
    u16* dp = (w < 64) ? (reinterpret_cast<u16*>(R + R_KMLA) + head * 64 + w) : (reinterpret_cast<u16*>(R + R_VMLA) + head * 64 + (w - 64));
    *reinterpret_cast<u32*>(dp + (size_t)row * 768) = pack2_old(v0 * s, v1 * s);
  }
}

DI void gemm_tile_coords(int L, int nwg, int nN, int& brow, int& bcol) {
  int wgid = L;
  const int q = nwg / 8, r = nwg % 8, xcd = wgid % 8, off = wgid / 8;
  wgid = (xcd < r ? xcd * (q + 1) : r * (q + 1) + (xcd - r) * q) + off;
  const int nig = 8 * nN, gid = wgid / nig, fm = gid * 8;
  const int pm = fm + ((wgid % nig) % 8), pn = (wgid % nig) / 8;
  brow = pm * 256; bcol = pn * 256;
}

template <int EPI>
DI void gemm_phase(const Params& p, const GemmDesc d, char* smem) {
  constexpr int BK = 64, HALF = 128, HT = HALF * BK;
  u16* shm = reinterpret_cast<u16*>(smem);
  const float* rs = reinterpret_cast<const float*>(p.ws + O_R + (EPI == EPI_UQ ? R_RSQ : R_RSKV));
  int tid_ = threadIdx.x;
  asm volatile("" : "+v"(tid_));
  const int tid = tid_;
  const int wid = tid >> 6, lane = tid & 63, wr = wid >> 2, wc = wid & 3, fr = lane & 15, fq = lane >> 4;
  const int K = d.K, lda = d.lda, nt = K / BK;
  const u16* A = d.A;
  const u16* Bt = d.Bt;
  const int nM = 128, nN = d.nN, nwg = nM * nN;
  constexpr int AH = (EPI == EPI_GU || EPI == EPI_IN1) ? 16 : 128;
  const int wbase = __builtin_amdgcn_readfirstlane(tid >> 6) * 1024;
  unsigned voA0, voA1, voB0, voB1;
  {
    int r0, c0, r1, c1;
    stage_rc(tid * 16, r0, c0);
    stage_rc(tid * 16 + 8192, r1, c1);
    const int pr0 = (EPI == EPI_GU || EPI == EPI_IN1) ? (((r0 >> 6) * 4 + ((r0 >> 2) & 3)) * 32 + ((r0 >> 4) & 3) * 4 + (r0 & 3)) : r0;
    const int pr1 = (EPI == EPI_GU || EPI == EPI_IN1) ? (((r1 >> 6) * 4 + ((r1 >> 2) & 3)) * 32 + ((r1 >> 4) & 3) * 4 + (r1 & 3)) : r1;
    voA0 = (unsigned)(pr0 * lda + c0) * 2u; voA1 = (unsigned)(pr1 * lda + c1) * 2u;
    voB0 = (unsigned)(r0 * K + c0) * 2u; voB1 = (unsigned)(r1 * K + c1) * 2u;
  }
#define SA(b, h) (shm + ((b) * 2 + (h)) * HT)
#define SB(b, h) (shm + (4 + (b) * 2 + (h)) * HT)
#define STAGE(P, BASE, LD, br, kt, VO0, VO1)                                                         \
  do {                                                                                               \
    const char* _sb = uniform_ptr((BASE) + (long)(br) * (LD) + (long)(kt) * BK);                     \
    __builtin_amdgcn_global_load_lds((const unsigned*)(_sb + (VO0)), (unsigned*)((char*)(P) + wbase), 16, 0, 0);        \
    __builtin_amdgcn_global_load_lds((const unsigned*)(_sb + (VO1)), (unsigned*)((char*)(P) + wbase + 8192), 16, 0, 0); \
  } while (0)
#define STA(P, br, kt) STAGE(P, A, lda, br, kt, voA0, voA1)
#define STB(P, br, kt) STAGE(P, Bt, K, br, kt, voB0, voB1)
#define LDA(dst, b, h)                                                                               \
  for (int m = 0; m < 4; ++m)                                                                        \
    for (int k = 0; k < 2; ++k)                                                                      \
      dst[m][k] = *reinterpret_cast<const bf16x8*>((char*)SA(b, h) + lds_byte(wr * 64 + m * 16 + fr, k * 32 + fq * 8))
#define LDB(dst, b, h)                                                                               \
  for (int n = 0; n < 2; ++n)                                                                        \
    for (int k = 0; k < 2; ++k)                                                                      \
      dst[n][k] = *reinterpret_cast<const bf16x8*>((char*)SB(b, h) + lds_byte(wc * 32 + n * 16 + fr, k * 32 + fq * 8))
#define MMA(ai, bj, At_, Bt_)                                                                        \
  do {                                                                                               \
    __builtin_amdgcn_s_setprio(1);                                                                   \
    for (int m = 0; m < 4; ++m)                                                                      \
      for (int n = 0; n < 2; ++n)                                                                    \
        for (int k = 0; k < 2; ++k)                                                                  \
          acc[ai][bj][m][n] = __builtin_amdgcn_mfma_f32_16x16x32_bf16(At_[m][k], Bt_[n][k], acc[ai][bj][m][n], 0, 0, 0); \
    __builtin_amdgcn_s_setprio(0);                                                                   \
  } while (0)
#define WAIT_V(n) asm volatile("s_waitcnt vmcnt(" #n ")" ::: "memory")
#define WAIT_L(n) asm volatile("s_waitcnt lgkmcnt(" #n ")" ::: "memory")
#define BAR __builtin_amdgcn_s_barrier()
#define SCHED __builtin_amdgcn_sched_barrier(0)

  int brow = 0, bcol = 0;
  if ((int)blockIdx.x < nwg) {
    gemm_tile_coords(blockIdx.x, nwg, nN, brow, bcol);
    STB(SB(0, 0), bcol, 0); STA(SA(0, 0), brow, 0);
    STB(SB(0, 1), bcol + HALF, 0); STA(SA(0, 1), brow + AH, 0);
  }
#pragma unroll 1
  for (int L = blockIdx.x; L < nwg; L += gridDim.x) {
    f32x4 acc[2][2][4][2];
#pragma unroll
    for (int a = 0; a < 2; ++a)
#pragma unroll
      for (int b = 0; b < 2; ++b)
#pragma unroll
        for (int m = 0; m < 4; ++m)
#pragma unroll
          for (int n = 0; n < 2; ++n) acc[a][b][m][n] = f32x4{0.f, 0.f, 0.f, 0.f};
    bf16x8 At[4][2], B0[2][2], B1[2][2];

    if (wr == 1) BAR;
    WAIT_V(0); BAR;
    STB(SB(1, 0), bcol, 1); STA(SA(1, 0), brow, 1); STB(SB(1, 1), bcol + HALF, 1);
    WAIT_V(6); BAR;
#pragma unroll 1
    for (int t = 0; t < nt - 2; t += 2) {
      LDB(B0, 0, 0); SCHED; LDA(At, 0, 0); STA(SA(1, 1), brow + AH, t + 1);
      WAIT_L(8); BAR; WAIT_L(0); MMA(0, 0, At, B0); BAR; SCHED;
      LDB(B1, 0, 1); STB(SB(0, 0), bcol, t + 2);
      BAR; WAIT_L(0); MMA(0, 1, At, B1); BAR;
      LDA(At, 0, 1); STA(SA(0, 0), brow, t + 2);
      BAR; WAIT_L(0); MMA(1, 0, At, B0); BAR; SCHED;
      STB(SB(0, 1), bcol + HALF, t + 2);
      WAIT_V(6); BAR; MMA(1, 1, At, B1); BAR;
      LDB(B0, 1, 0); SCHED; LDA(At, 1, 0); STA(SA(0, 1), brow + AH, t + 2);
      WAIT_L(8); BAR; WAIT_L(0); MMA(0, 0, At, B0); BAR; SCHED;
      LDB(B1, 1, 1); STB(SB(1, 0), bcol, t + 3);
      BAR; WAIT_L(0); MMA(0, 1, At, B1); BAR;
      LDA(At, 1, 1); STA(SA(1, 0), brow, t + 3);
      BAR; WAIT_L(0); MMA(1, 0, At, B0); BAR; SCHED;
      STB(SB(1, 1), bcol + HALF, t + 3);
      WAIT_V(6); BAR; MMA(1, 1, At, B1); BAR;
    }
    {
      LDB(B0, 0, 0); LDA(At, 0, 0); STA(SA(1, 1), brow + AH, nt - 1);
      BAR; WAIT_L(0); MMA(0, 0, At, B0); BAR;
      LDB(B1, 0, 1); BAR; WAIT_L(0); MMA(0, 1, At, B1); BAR;
      LDA(At, 0, 1); WAIT_V(4); BAR; WAIT_L(0); MMA(1, 0, At, B0); MMA(1, 1, At, B1); BAR;
    }
    {
      LDB(B0, 1, 0); LDA(At, 1, 0); WAIT_V(2); BAR; WAIT_L(0); MMA(0, 0, At, B0); BAR;
      LDB(B1, 1, 1); WAIT_V(0); BAR; WAIT_L(0); MMA(0, 1, At, B1); BAR;
      LDA(At, 1, 1); BAR; WAIT_L(0); MMA(1, 0, At, B0); MMA(1, 1, At, B1); BAR;
    }
    if (wr == 0) BAR;
    const int crow0 = brow, ccol0 = bcol;
    if (L + (int)gridDim.x < nwg) {
      gemm_tile_coords(L + gridDim.x, nwg, nN, brow, bcol);
      STB(SB(0, 0), bcol, 0); STA(SA(0, 0), brow, 0);
      STB(SB(0, 1), bcol + HALF, 0); STA(SA(0, 1), brow + AH, 0);
    }
    {
      const int t2 = opaque_tid();
      const int wid2 = t2 >> 6, ln2 = t2 & 63, wr2 = wid2 >> 2, wc2 = wid2 & 3, fr2 = ln2 & 15, fq2 = ln2 >> 4;
      if (EPI == EPI_GU || EPI == EPI_IN1) {
        float* sS = reinterpret_cast<float*>(smem + 131072) + 768;
        if (t2 < 256) {
          const float4 q4 = reinterpret_cast<const float4*>(d.ss)[crow0 + t2];
          sS[t2] = rsqrtf((q4.x + q4.y + q4.z + q4.w) * (1.f / 1024.f) + EPS_);
        }
        __syncthreads();
        const float* sp = sS + (wr2 * 4 + fq2) * 32;
#pragma unroll
        for (int ai = 0; ai < 2; ++ai)
#pragma unroll
          for (int m = 0; m < 4; ++m) {
            const float4 s4 = *reinterpret_cast<const float4*>(sp + ai * 16 + m * 4);
            const float sv[4] = {s4.x, s4.y, s4.z, s4.w};
#pragma unroll
            for (int j = 0; j < 4; ++j)
#pragma unroll
              for (int bj = 0; bj < 2; ++bj) { acc[ai][bj][m][0][j] *= sv[j]; acc[ai][bj][m][1][j] *= sv[j]; }
          }
      }
      if (EPI == EPI_RES) {
#pragma unroll
        for (int ai = 0; ai < 2; ++ai) {
          float2 xin[4][4][2];
#pragma unroll
          for (int m = 0; m < 4; ++m)
#pragma unroll
            for (int j = 0; j < 4; ++j)
#pragma unroll
              for (int bj = 0; bj < 2; ++bj) {
                const size_t idx = (size_t)(crow0 + ai * HALF + wr2 * 64 + m * 16 + fq2 * 4 + j) * 1024 + ccol0 + bj * HALF + wc2 * 32 + 2 * fr2;
                if (d.res16) {
                  const u32 w = *reinterpret_cast<const u32*>(d.res16 + idx);
                  xin[m][j][bj] = make_float2(bflo(w), bfhi(w));
                } else {
                  xin[m][j][bj] = *reinterpret_cast<const float2*>(d.res + idx);
                }
              }
          asm volatile("" ::: "memory");
#pragma unroll
          for (int m = 0; m < 4; ++m)
#pragma unroll
            for (int j = 0; j < 4; ++j) {
              const int row = crow0 + ai * HALF + wr2 * 64 + m * 16 + fq2 * 4 + j;
              float sq = 0.f;
#pragma unroll
              for (int bj = 0; bj < 2; ++bj) {
                const size_t idx = (size_t)row * 1024 + ccol0 + bj * HALF + wc2 * 32 + 2 * fr2;
                float x0 = xin[m][j][bj].x + acc[ai][bj][m][0][j], x1 = xin[m][j][bj].y + acc[ai][bj][m][1][j];
                if (d.dst) *reinterpret_cast<float2*>(d.dst + idx) = make_float2(x0, x1);
                if (d.xb) {
                  const u32 w = pack2(x0, x1);
                  *reinterpret_cast<u32*>(d.xb + idx) = w;
                  x0 = bflo(w); x1 = bfhi(w);
                }
                sq += x0 * x0 + x1 * x1;
              }
              if (d.ss) {
                sq += __shfl_xor(sq, 1); sq += __shfl_xor(sq, 2); sq += __shfl_xor(sq, 4); sq += __shfl_xor(sq, 8);
                if (fr2 == 0) reinterpret_cast<float*>(smem + 131072)[wc2 * 256 + (row - crow0)] = sq;
              }
            }
        }
        if (d.ss) {
          __syncthreads();
          if (t2 < 256) {
            const float* e = reinterpret_cast<const float*>(smem + 131072) + t2;
            d.ss[(size_t)(crow0 + t2) * 4 + (ccol0 >> 8)] = e[0] + e[256] + e[512] + e[768];
          }
        }
      } else if (EPI == EPI_IN1) {
        char* R = p.ws + O_R;
        float* ex = reinterpret_cast<float*>(smem + 131072);
        const int mt = crow0 >> 8;
        const int tk0 = crow0 + (wr2 * 4 + fq2) * 32;
        const bool has_x = (ccol0 + 256 > 1024) && (ccol0 < 2560);
        if (has_x) {
          if (wr2 == 0 && fq2 == 3) {
#pragma unroll
            for (int bj = 0; bj < 2; ++bj)
#pragma unroll
              for (int nb = 0; nb < 2; ++nb)
#pragma unroll
                for (int r = 0; r < 3; ++r) ex[((((bj * 4 + wc2) * 16 + fr2) * 2 + nb) * 3) + r] = acc[1][bj][3][nb][1 + r];
          }
          __syncthreads();
        }
        const bool tile_head = (wr2 == 0 && fq2 == 0);
#pragma unroll
        for (int bj = 0; bj < 2; ++bj) {
          const int c0 = ccol0 + bj * HALF + wc2 * 32 + 2 * fr2;
          if (c0 < 1024) {
            u16* zp = reinterpret_cast<u16*>(R + R_Z) + (size_t)tk0 * 1024 + c0;
#pragma unroll
            for (int ai = 0; ai < 2; ++ai)
#pragma unroll
              for (int m = 0; m < 4; ++m)
#pragma unroll
                for (int j = 0; j < 4; ++j)
                  *reinterpret_cast<u32*>(zp + (size_t)(ai * 16 + m * 4 + j) * 1024) = pack2(acc[ai][bj][m][0][j], acc[ai][bj][m][1][j]);
          } else if (c0 < 2560) {
            const int xcn = c0 - 1024;
            const float* cw = reinterpret_cast<const float*>(p.in[17]);
            const float* cbias = reinterpret_cast<const float*>(p.in[18]);
            float ov[2][32];
#pragma unroll
            for (int nb = 0; nb < 2; ++nb) {
              const int ch = xcn + nb;
              const float b = cbias[ch], w0 = cw[ch], w1 = cw[1536 + ch], w2 = cw[2 * 1536 + ch], w3 = cw[3 * 1536 + ch];
              float g3 = __shfl(acc[1][bj][3][nb][1], (ln2 - 16) & 63);
              float g2 = __shfl(acc[1][bj][3][nb][2], (ln2 - 16) & 63);
              float g1 = __shfl(acc[1][bj][3][nb][3], (ln2 - 16) & 63);
              if (wr2 == 1 && fq2 == 0) {
                const float* e = ex + ((((bj * 4 + wc2) * 16 + fr2) * 2 + nb) * 3);
                g3 = e[0]; g2 = e[1]; g1 = e[2];
              }
              if (tile_head) {
                float* hx = reinterpret_cast<float*>(R + R_HEADX) + ((size_t)mt * 3) * 1536 + ch;
                hx[0] = acc[0][bj][0][nb][0]; hx[1536] = acc[0][bj][0][nb][1]; hx[2 * 1536] = acc[0][bj][0][nb][2];
              }
              if (wr2 == 1 && fq2 == 3) {
                float* tx = reinterpret_cast<float*>(R + R_TAILX) + ((size_t)mt * 3) * 1536 + ch;
                tx[0] = acc[1][bj][3][nb][1]; tx[1536] = acc[1][bj][3][nb][2]; tx[2 * 1536] = acc[1][bj][3][nb][3];
              }
#pragma unroll
              for (int ai = 0; ai < 2; ++ai)
#pragma unroll
                for (int m = 0; m < 4; ++m)
#pragma unroll
                  for (int j = 0; j < 4; ++j) {
                    const float g = acc[ai][bj][m][nb][j];
                    ov[nb][ai * 16 + m * 4 + j] = siluf(b + w0 * g3 + w1 * g2 + w2 * g1 + w3 * g);
                    g3 = g2; g2 = g1; g1 = g;
                  }
            }
            u16* xp = reinterpret_cast<u16*>(R + R_XBCC) + (size_t)tk0 * 1536 + xcn;
#pragma unroll
            for (int k = 0; k < 32; ++k)
              if (!(tile_head && k < 3)) *reinterpret_cast<u32*>(xp + (size_t)k * 1536) = pack2(ov[0][k], ov[1][k]);
          } else if (c0 < 2576) {
            const float* dt_bias = reinterpret_cast<const float*>(p.in[19]);
            const float b0 = dt_bias[c0 - 2560], b1 = dt_bias[c0 - 2559];
            float* dp = reinterpret_cast<float*>(R + R_DT) + (size_t)tk0 * 16 + (c0 - 2560);
#pragma unroll
            for (int ai = 0; ai < 2; ++ai)
#pragma unroll
              for (int m = 0; m < 4; ++m)
#pragma unroll
                for (int j = 0; j < 4; ++j) {
                  const float u0 = acc[ai][bj][m][0][j] + b0, u1 = acc[ai][bj][m][1][j] + b1;
                  float* q = dp + (size_t)(ai * 16 + m * 4 + j) * 16;
                  q[0] = fmaxf(u0, 0.f) + LN2_ * lg2(1.f + ex2(-fabsf(u0) * LOG2E_));
                  q[1] = fmaxf(u1, 0.f) + LN2_ * lg2(1.f + ex2(-fabsf(u1) * LOG2E_));
                }
          } else if (c0 < 4112) {
            u16* qp = reinterpret_cast<u16*>(R + R_QKV1) + (size_t)tk0 * 1536 + (c0 - 2576);
#pragma unroll
            for (int ai = 0; ai < 2; ++ai)
#pragma unroll
              for (int m = 0; m < 4; ++m)
#pragma unroll
                for (int j = 0; j < 4; ++j)
                  *reinterpret_cast<u32*>(qp + (size_t)(ai * 16 + m * 4 + j) * 1536) = pack2(acc[ai][bj][m][0][j], acc[ai][bj][m][1][j]);
          }
        }
      } else if (EPI == EPI_GU) {
        char* R = p.ws + O_R;
        const float* cw = d.res;
        const float* cbias = d.dst;
        float* ex = reinterpret_cast<float*>(smem + 131072);
        const int mt = crow0 >> 8;
        const int tk0 = crow0 + (wr2 * 4 + fq2) * 32;
        const int ch0 = (ccol0 >> 8) * 128 + (wc2 * 16 + fr2) * 2;
        if (wr2 == 0 && fq2 == 3) {
#pragma unroll
          for (int bj = 0; bj < 2; ++bj) {
            ex[((bj * 4 + wc2) * 16 + fr2) * 2] = acc[1][bj][3][0][2];
            ex[((bj * 4 + wc2) * 16 + fr2) * 2 + 1] = acc[1][bj][3][0][3];
          }
        }
        __syncthreads();
        const bool tile_head = (wr2 == 0 && fq2 == 0);
        u16* actp = reinterpret_cast<u16*>(R + R_GU) + (size_t)tk0 * 2816 + ch0;
        float a_out[2][32];
#pragma unroll
        for (int bj = 0; bj < 2; ++bj) {
          const int ch = ch0 + bj;
          const float b = cbias[ch], w0 = cw[ch], w1 = cw[2816 + ch], w2 = cw[2 * 2816 + ch];
          float gm1 = __shfl(acc[1][bj][3][0][3], (ln2 - 16) & 63);
          float gm2 = __shfl(acc[1][bj][3][0][2], (ln2 - 16) & 63);
          if (wr2 == 1 && fq2 == 0) {
            gm2 = ex[((bj * 4 + wc2) * 16 + fr2) * 2];
            gm1 = ex[((bj * 4 + wc2) * 16 + fr2) * 2 + 1];
          }
          if (tile_head) {
            float* hg = reinterpret_cast<float*>(R + R_HEADG) + ((size_t)mt * 2) * 2816 + ch;
            float* hu = reinterpret_cast<float*>(R + R_HEADU) + ((size_t)mt * 2) * 2816 + ch;
            hg[0] = acc[0][bj][0][0][0]; hg[2816] = acc[0][bj][0][0][1];
            hu[0] = acc[0][bj][0][1][0]; hu[2816] = acc[0][bj][0][1][1];
          }
          if (wr2 == 1 && fq2 == 3) {
            float* tg = reinterpret_cast<float*>(R + R_TAILG) + ((size_t)mt * 2) * 2816 + ch;
            tg[0] = acc[1][bj][3][0][2]; tg[2816] = acc[1][bj][3][0][3];
          }
#pragma unroll
          for (int ai = 0; ai < 2; ++ai)
#pragma unroll
            for (int m = 0; m < 4; ++m)
#pragma unroll
              for (int j = 0; j < 4; ++j) {
                const float g = acc[ai][bj][m][0][j];
                const float v = b + w0 * gm2 + w1 * gm1 + w2 * g;
                a_out[bj][ai * 16 + m * 4 + j] = siluf(v) * acc[ai][bj][m][1][j];
                gm2 = gm1; gm1 = g;
              }
        }
#pragma unroll
        for (int k = 0; k < 32; ++k)
          if (!(tile_head && k < 2))
            *reinterpret_cast<u32*>(actp + (size_t)k * 2816) = pack2(a_out[0][k], a_out[1][k]);
      } else {
#pragma unroll
        for (int ai = 0; ai < 2; ++ai) {
          float2 csr[4][4];
          float rsr[4][4];
#pragma unroll
          for (int m = 0; m < 4; ++m)
#pragma unroll
            for (int j = 0; j < 4; ++j) {
              const int row = crow0 + ai * HALF + wr2 * 64 + m * 16 + fq2 * 4 + j;
              csr[m][j] = make_float2(1.f, 0.f);
              rsr[m][j] = 1.f;
              if (EPI == EPI_IN0) csr[m][j] = reinterpret_cast<const float2*>(p.ws + O_ROPE)[(size_t)row * 32 + (wc2 & 1) * 16 + fr2];
              if (EPI == EPI_UQ) csr[m][j] = reinterpret_cast<const float2*>(p.ws + O_ROPE)[(size_t)row * 32 + 2 * fr2];
              if (EPI == EPI_UQ || EPI == EPI_UKV) rsr[m][j] = rs[row];
            }
          asm volatile("" ::: "memory");
#pragma unroll
          for (int bj = 0; bj < 2; ++bj)
#pragma unroll
            for (int m = 0; m < 4; ++m)
#pragma unroll
              for (int j = 0; j < 4; ++j)
                gemm_store<EPI>(p, d, crow0 + ai * HALF + wr2 * 64 + m * 16 + fq2 * 4 + j, ccol0 + bj * HALF + wc2 * 32, fr2,
                                acc[ai][bj][m][0][j], acc[ai][bj][m][1][j], csr[m][j], rsr[m][j]);
        }
      }
    }
  }
#undef SA
#undef SB
#undef STAGE
#undef STA
#undef STB
#undef LDA
#undef LDB
#undef MMA
}

template <int MODE>
DI void attn_phase(const Params& p, char* smem) {
  constexpr int DK = (MODE == 0) ? 96 : 64;
  constexpr int NKS = DK / 16;
  constexpr int KSTR = (DK + 8) * 2;
  constexpr int NKCH = DK / 8;
  constexpr int VSTR = 136;
  constexpr int STG = 64 * KSTR + 64 * VSTR;
  char* R = p.ws + O_R;
  int tid_ = threadIdx.x;
  asm volatile("" : "+v"(tid_));
  const int tid = tid_, lane = tid & 63, wave = tid >> 6, l31 = lane & 31, hh = lane >> 5;
  const int nitems = (MODE == 2) ? 1024 : 1536;
  for (int L = blockIdx.x; L < nitems; L += gridDim.x) {
    int b, head, qb, dil = 1, rr = 0, grp = 0, jh = 0;
    if (MODE == 0) {
      const int rnd = L / (int)gridDim.x, pos = L % (int)gridDim.x;
      const bool whole = (nitems % (int)gridDim.x) == 0;
      const int idx = (whole && (rnd & 1)) ? (rnd * (int)gridDim.x + (int)gridDim.x - 1 - pos) : L;
      qb = 15 - idx / 96; const int bh = idx % 96; b = bh / 12; head = bh % 12;
    }
    else if (MODE == 2) { qb = 15 - L / 64; const int bh = L % 64; b = bh >> 3; head = bh & 7; }
    else {
      b = L / 192; const int r1 = L % 192; grp = r1 >> 6; const int r2 = r1 & 63; jh = r2 >> 4; const int u = r2 & 15;
      dil = (grp == 0) ? 1 : (grp == 1 ? 4 : 16);
      rr = u % dil; qb = u / dil; head = grp * 4 + jh;
    }
    const size_t tokb = (size_t)b * SEQ_;
    const u16 *Qb, *Kb, *Vb, *K2b = nullptr;
    size_t qstr, kstr;
    if (MODE == 0) {
      Qb = reinterpret_cast<const u16*>(R + R_QMLA) + tokb * 1152 + head * 96; qstr = 1152;
      Kb = reinterpret_cast<const u16*>(R + R_KMLA) + tokb * 768 + head * 64; kstr = 768;
      Vb = reinterpret_cast<const u16*>(R + R_VMLA) + tokb * 768 + head * 64;
      K2b = reinterpret_cast<const u16*>(R + R_KPE) + tokb * 32;
    } else if (MODE == 1) {
      Qb = reinterpret_cast<const u16*>(R + R_QKV0) + (tokb + rr) * 2304 + head * 64; qstr = (size_t)dil * 2304;
      Kb = Qb + 768; Vb = Qb + 1536; kstr = qstr;
    } else {
      Qb = reinterpret_cast<const u16*>(R + R_QKV1) + tokb * 1536 + head * 64; qstr = 1536;
      Kb = Qb + 512; Vb = Qb + 1024; kstr = 1536;
    }
    int first, step, count;
    if (MODE == 0) { first = 0; step = 64; count = 4 * qb + 4; }
    else if (MODE == 1) { first = (qb == 0) ? 0 : 256 * qb - 128; step = 64; count = (qb == 0) ? 4 : 6; }
    else { first = 64 * (4 * qb + 3); step = -64; count = 4 * qb + 4; }
    const int iq0 = 256 * qb + 32 * wave;
    const int iq = iq0 + l31;

    bf16x8 qf[NKS];
    {
      const u16* qp = Qb + (size_t)iq * qstr + hh * 8;
#pragma unroll
      for (int ks = 0; ks < NKS; ++ks) qf[ks] = *reinterpret_cast<const bf16x8*>(qp + ks * 16);
    }
    f32x16 o[2];
#pragma unroll
    for (int db = 0; db < 2; ++db)
#pragma unroll
      for (int i = 0; i < 16; ++i) o[db][i] = 0.f;
    float m_run = -1e30f, l_run = 0.f, Rsum = 1.f;

    uint4 kreg0, kreg1 = make_uint4(0, 0, 0, 0), vreg0 = make_uint4(0, 0, 0, 0), vreg1 = make_uint4(0, 0, 0, 0);
#define ATT_GLOAD(ik0_)                                                                               \
  do {                                                                                               \
    {                                                                                                \
      const int row_ = tid / NKCH, kc_ = tid % NKCH;                                                 \
      const size_t ik_ = (size_t)((ik0_) + row_);                                                    \
      const u16* s_;                                                                                 \
      if (MODE == 0) s_ = (kc_ < 8) ? (Kb + ik_ * 768 + kc_ * 8) : (K2b + ik_ * 32 + (kc_ - 8) * 8);  \
      else s_ = Kb + ik_ * kstr + kc_ * 8;                                                           \
      kreg0 = *reinterpret_cast<const uint4*>(s_);                                                   \
    }                                                                                                \
    if (MODE == 0 && tid < 256) {                                                                    \
      const int c_ = tid + 512, row_ = c_ / NKCH, kc_ = c_ % NKCH;                                   \
      const size_t ik_ = (size_t)((ik0_) + row_);                                                    \
      const u16* s_ = (kc_ < 8) ? (Kb + ik_ * 768 + kc_ * 8) : (K2b + ik_ * 32 + (kc_ - 8) * 8);      \
      kreg1 = *reinterpret_cast<const uint4*>(s_);                                                   \
    }                                                                                                \
    if (tid < 256) {                                                                                 \
      const int kg_ = tid & 31, dg_ = tid >> 5;                                                      \
      vreg0 = *reinterpret_cast<const uint4*>(Vb + (size_t)((ik0_) + 2 * kg_) * kstr + dg_ * 8);     \
      vreg1 = *reinterpret_cast<const uint4*>(Vb + (size_t)((ik0_) + 2 * kg_ + 1) * kstr + dg_ * 8); \
    }                                                                                                \
  } while (0)
#define ATT_VW(w_, av_, cv_)                                                                          \
  do {                                                                                               \
    *reinterpret_cast<u32*>(VtW + (dg_ * 8 + 2 * (w_)) * VSTR + kg_ * 4) = ((av_) & 0xffffu) | ((cv_) << 16);          \
    *reinterpret_cast<u32*>(VtW + (dg_ * 8 + 2 * (w_) + 1) * VSTR + kg_ * 4) = ((av_) >> 16) | ((cv_) & 0xffff0000u);  \
  } while (0)
#define ATT_SWRITE()                                                                                  \
  do {                                                                                               \
    *reinterpret_cast<uint4*>(KsW + (tid / NKCH) * KSTR + (tid % NKCH) * 16) = kreg0;                 \
    if (MODE == 0 && tid < 256)                                                                      \
      *reinterpret_cast<uint4*>(KsW + ((tid + 512) / NKCH) * KSTR + ((tid + 512) % NKCH) * 16) = kreg1; \
    if (tid < 256) {                                                                                 \
      const int kg_ = tid & 31, dg_ = tid >> 5;                                                      \
      ATT_VW(0, vreg0.x, vreg1.x); ATT_VW(1, vreg0.y, vreg1.y);                                      \
      ATT_VW(2, vreg0.z, vreg1.z); ATT_VW(3, vreg0.w, vreg1.w);                                      \
    }                                                                                                \
  } while (0)
    volatile int* flg = reinterpret_cast<volatile int*>(smem + 49152);
    ATT_GLOAD(first);
    __syncthreads();
    {
      char* KsW = smem; char* VtW = smem + 64 * KSTR;
      ATT_SWRITE();
      if (MODE == 2 && tid == 0) { flg[0] = 1; flg[1] = 1; }
    }
    __syncthreads();
    for (int j = 0; j < count; ++j) {
      const int ik0 = first + j * step;
      const char* Ks = smem + (j & 1) * STG;
      const char* Vt = Ks + 64 * KSTR;
      if (MODE == 2) {
        if (j > 0 && flg[(j - 1) % 3] != 0) break;
        if (tid == 0) flg[(j + 1) % 3] = 1;
      }
      if (j + 1 < count) ATT_GLOAD(ik0 + step);

      bool skip;
      if (MODE == 0) skip = ik0 > iq0 + 31;
      else if (MODE == 1) skip = (ik0 > iq0 + 31) || (ik0 + 63 < iq0 - 128);
      else skip = ik0 >= iq0 + 31;
      if (skip) {
        if (MODE == 2) flg[j % 3] = 0;
      } else {
      f32x16 st[2];
      bf16x8 kf[2][NKS];
#pragma unroll
      for (int kb = 0; kb < 2; ++kb) {
        const char* kp = Ks + (kb * 32 + l31) * KSTR + hh * 16;
#pragma unroll
        for (int ks = 0; ks < NKS; ++ks) kf[kb][ks] = *reinterpret_cast<const bf16x8*>(kp + ks * 32);
      }
      __builtin_amdgcn_sched_barrier(0);
#pragma unroll
      for (int kb = 0; kb < 2; ++kb)
#pragma unroll
        for (int i = 0; i < 16; ++i) st[kb][i] = 0.f;
#pragma unroll
      for (int ks = 0; ks < NKS; ++ks) {
        st[0] = MFMA32(kf[0][ks], qf[ks], st[0]);
        st[1] = MFMA32(kf[1][ks], qf[ks], st[1]);
      }
      __builtin_amdgcn_sched_barrier(0);
      uint4 vf[4][2];
#pragma unroll
      for (int s4 = 0; s4 < 4; ++s4)
#pragma unroll
        for (int db = 0; db < 2; ++db) {
          const char* vp = Vt + (db * 32 + l31) * VSTR + s4 * 32 + hh * 8;
          const uint2 lo = *reinterpret_cast<const uint2*>(vp);
          const uint2 hi = *reinterpret_cast<const uint2*>(vp + 16);
          vf[s4][db] = make_uint4(lo.x, lo.y, hi.x, hi.y);
        }
      __builtin_amdgcn_sched_barrier(0);

      if (MODE != 2) {
        const float sc = ((MODE == 0) ? 0.10206207261596577f : 0.125f) * LOG2E_;
        const bool need_mask = (MODE == 1) || (__builtin_amdgcn_readfirstlane((int)(ik0 + 63 > iq0)) != 0);
        if (need_mask) {
#pragma unroll
          for (int kb = 0; kb < 2; ++kb)
#pragma unroll
            for (int i = 0; i < 16; ++i) {
              const int ik = ik0 + kb * 32 + crow(i, hh);
              bool valid = ik <= iq;
              if (MODE == 1) valid = valid && (iq - ik <= 128);
              st[kb][i] = valid ? st[kb][i] : -1e30f;
            }
          asm volatile("" ::: "memory");
        }
        float mxr = -1e30f;
#pragma unroll
        for (int kb = 0; kb < 2; ++kb)
#pragma unroll
          for (int i = 0; i < 16; ++i) mxr = fmaxf(mxr, st[kb][i]);
        float mx = fmaxf(m_run, (mxr > -1e29f) ? mxr * sc : -1e30f);
        mx = fmaxf(mx, __shfl_xor(mx, 32));
        const float alpha = ex2(m_run - mx);
        m_run = mx;
        float ps = 0.f;
#pragma unroll
        for (int kb = 0; kb < 2; ++kb)
#pragma unroll
          for (int i = 0; i < 16; ++i) {
            const float v = st[kb][i];
            const float pv = (MODE == 0 || v > -1e29f) ? ex2(fmaf(v, sc, -mx)) : 0.f;
            st[kb][i] = pv;
            ps += pv;
          }
        l_run = l_run * alpha + ps;
        if (!__all(alpha == 1.f)) {
#pragma unroll
          for (int db = 0; db < 2; ++db)
#pragma unroll
            for (int i = 0; i < 16; ++i) o[db][i] *= alpha;
        }
      } else {
        float own[8], par[8];
        float omv[2][16];
#pragma unroll
        for (int kb = 0; kb < 2; ++kb)
#pragma unroll
          for (int g = 0; g < 4; ++g) {
            float gp = 1.f;
#pragma unroll
            for (int e = 0; e < 4; ++e) {
              const int i = g * 4 + e;
              const int ik = ik0 + kb * 32 + crow(i, hh);
              const float z = st[kb][i] * 0.125f;
              const float ee = ex2(-fabsf(z) * LOG2E_);
              const float r = __builtin_amdgcn_rcpf(1.f + ee);
              const float er = ee * r;
              const bool pos = z >= 0.f, valid = ik < iq;
              const float beta = pos ? r : er, om = pos ? er : r;
              omv[kb][i] = valid ? om : 1.f;
              st[kb][i] = valid ? beta : 0.f;
              gp *= omv[kb][i];
            }
            own[kb * 4 + g] = gp;
          }
#pragma unroll
        for (int a = 0; a < 8; ++a) par[a] = __shfl_xor(own[a], 32);
        float run = 1.f, sg[8];
#pragma unroll
        for (int a = 7; a >= 0; --a) {
          const float g_odd = hh ? own[a] : par[a];
          const float g_even = hh ? par[a] : own[a];
          const float sg_odd = run; run *= g_odd;
          const float sg_even = run; run *= g_even;
          sg[a] = hh ? sg_odd : sg_even;
        }
#pragma unroll
        for (int kb = 0; kb < 2; ++kb)
#pragma unroll
          for (int g = 0; g < 4; ++g) {
            float aft = Rsum * sg[kb * 4 + g];
#pragma unroll
            for (int e = 3; e >= 0; --e) {
              const int i = g * 4 + e;
              st[kb][i] *= aft;
              aft *= omv[kb][i];
            }
          }
        Rsum *= run;
      }

#pragma unroll
      for (int s4 = 0; s4 < 4; ++s4) {
        const int kb = s4 >> 1, base = (s4 & 1) * 8;
        uint4 pw;
        pw.x = pack2(st[kb][base + 0], st[kb][base + 1]);
        pw.y = pack2(st[kb][base + 2], st[kb][base + 3]);
        pw.z = pack2(st[kb][base + 4], st[kb][base + 5]);
        pw.w = pack2(st[kb][base + 6], st[kb][base + 7]);
        const bf16x8 pf = as_bf16x8(pw);
#pragma unroll
        for (int db = 0; db < 2; ++db) o[db] = MFMA32(as_bf16x8(vf[s4][db]), pf, o[db]);
      }
      if (MODE == 2) {
        if ((Rsum != 0.f)) flg[j % 3] = 0;
      }
      }
      if (j + 1 < count) {
        char* KsW = smem + ((j + 1) & 1) * STG; char* VtW = KsW + 64 * KSTR;
        ATT_SWRITE();
      }
      __syncthreads();
    }

    float inv = 1.f;
    if (MODE != 2) {
      const float lt = l_run + __shfl_xor(l_run, 32);
      inv = 1.f / lt;
      if (MODE == 1 && hh == 0) {
        float* lse = reinterpret_cast<float*>(R + R_LSE);
        const size_t tok = tokb + (size_t)iq * dil + rr;
        lse[((size_t)grp * T_ + tok) * 4 + jh] = LN2_ * (m_run + lg2(lt));
      }
    }
    if (MODE == 1) {
      float* dst = reinterpret_cast<float*>(R + R_DSWO);
      const size_t tok = tokb + (size_t)iq * dil + rr;
      float* dp = dst + (((size_t)grp * T_ + tok) * 4 + jh) * 64;
#pragma unroll
      for (int db = 0; db < 2; ++db)
#pragma unroll
        for (int g = 0; g < 4; ++g) {
          const int d0 = db * 32 + 8 * g + 4 * hh;
          *reinterpret_cast<float4*>(dp + d0) =
              make_float4(o[db][4 * g] * inv, o[db][4 * g + 1] * inv, o[db][4 * g + 2] * inv, o[db][4 * g + 3] * inv);
        }
    } else {
      u16* dp;
      if (MODE == 0) dp = reinterpret_cast<u16*>(p.ws + O_HN) + (tokb + iq) * 1024 + 256 + head * 64;
      else dp = reinterpret_cast<u16*>(R + R_YCAT1) + (tokb + iq) * 1536 + 1024 + head * 64;
#pragma unroll
      for (int db = 0; db < 2; ++db)
#pragma unroll
        for (int g = 0; g < 4; ++g) {
          const int d0 = db * 32 + 8 * g + 4 * hh;
          uint2 w;
          w.x = pack2(o[db][4 * g] * inv, o[db][4 * g + 1] * inv);
          w.y = pack2(o[db][4 * g + 2] * inv, o[db][4 * g + 3] * inv);
          *reinterpret_cast<uint2*>(dp + d0) = w;
        }
    }
  }
}

DI void ssd_scan_dt(const float* dtc, int head, float Aneg, int lane, float* csS, float* dtS) {
  const float d0 = dtc[(unsigned)(2 * lane * 16 + head)], d1 = dtc[(unsigned)((2 * lane + 1) * 16 + head)];
  const float a0 = d0 * Aneg, a1 = d1 * Aneg;
  float s = a0 + a1;
#pragma unroll
  for (int off = 1; off < 64; off <<= 1) {
    const float v = __shfl_up(s, off);
    if (lane >= off) s += v;
  }
  csS[2 * lane] = s - a1; csS[2 * lane + 1] = s;
  dtS[2 * lane] = d0; dtS[2 * lane + 1] = d1;
}

DI void ssd_stage_half(const uint4 (&br)[4], const uint4 (&xr)[2], int h2, int kc, int rb, int kx, int rx, float cs_end,
                       const float* csS, const float* dtS, char* BTs, char* xT) {
  float w0, w1, w2, w3;
  {
    const int s = 64 * h2 + rb * 4;
    w0 = dtS[s] * ex2((cs_end - csS[s]) * LOG2E_);
    w1 = dtS[s + 1] * ex2((cs_end - csS[s + 1]) * LOG2E_);
    w2 = dtS[s + 2] * ex2((cs_end - csS[s + 2]) * LOG2E_);
    w3 = dtS[s + 3] * ex2((cs_end - csS[s + 3]) * LOG2E_);
  }
  char* bt = BTs + (kc * 8) * 272 + (64 * h2 + rb * 4) * 2;
#define SSD_BT(e_, c_, f_)                                                                              \
  do {                                                                                                 \
    uint2 w_;                                                                                          \
    w_.x = pack2(f_(br[0].c_) * w0, f_(br[1].c_) * w1);                                                 \
    w_.y = pack2(f_(br[2].c_) * w2, f_(br[3].c_) * w3);                                                 \
    *reinterpret_cast<uint2*>(bt + (e_) * 272) = w_;                                                   \
  } while (0)
  SSD_BT(0, x, bflo); SSD_BT(1, x, bfhi); SSD_BT(2, y, bflo); SSD_BT(3, y, bfhi);
  SSD_BT(4, z, bflo); SSD_BT(5, z, bfhi); SSD_BT(6, w, bflo); SSD_BT(7, w, bfhi);
#undef SSD_BT
  char* xt = xT + (kx * 8) * 272 + (64 * h2 + rx * 2) * 2;
#define SSD_XT(w_, c_)                                                                                  \
  do {                                                                                                 \
    *reinterpret_cast<u32*>(xt + (2 * (w_)) * 272) = (xr[0].c_ & 0xffffu) | (xr[1].c_ << 16);           \
    *reinterpret_cast<u32*>(xt + (2 * (w_) + 1) * 272) = (xr[0].c_ >> 16) | (xr[1].c_ & 0xffff0000u);   \
  } while (0)
  SSD_XT(0, x); SSD_XT(1, y); SSD_XT(2, z); SSD_XT(3, w);
#undef SSD_XT
}

DI void ssd_states_phase(const Params& p, char* smem) {
  char* R = p.ws + O_R;
  const u16* xc = reinterpret_cast<const u16*>(R + R_XBCC);
  const float* dtb = reinterpret_cast<const float*>(R + R_DT);
  u16* stb = reinterpret_cast<u16*>(p.ws + O_HN);
  float* dec = reinterpret_cast<float*>(R + R_DEC);
  const int tid_ = opaque_tid();
  const int sub = tid_ >> 8;
  smem += sub * 53248;
  const int tid = tid_ & 255, lane = tid & 63, wave = tid >> 6, l31 = lane & 31, hh = lane >> 5;
  char* BTs = smem;
  char* xT = smem + 34816;
  float* csS = reinterpret_cast<float*>(smem + 52224);
  float* dtS = csS + 128;
#pragma unroll 1
  for (int base = blockIdx.x * 2; base < 4096; base += gridDim.x * 2) {
    const int item = base + sub, head = item & 15, grp = head >> 3;
    const size_t t0 = (size_t)(item >> 4) * 128;
    const u16* xcb = xc + (size_t)(unsigned)__builtin_amdgcn_readfirstlane((int)(t0 * 1536));
    const float Aneg = -__expf(reinterpret_cast<const float*>(p.in[20])[head]);
    if (wave == 0) ssd_scan_dt(dtb + (size_t)(unsigned)__builtin_amdgcn_readfirstlane((int)(t0 * 16)), head, Aneg, lane, csS, dtS);
    const int kc = tid & 15, rb = tid >> 4, kx = tid & 7, rx = tid >> 3;
    uint4 br0[4], br1[4], xr0[2], xr1[2];
#pragma unroll
    for (int i = 0; i < 4; ++i) {
      br0[i] = *reinterpret_cast<const uint4*>(xcb + (unsigned)((rb * 4 + i) * 1536 + 1024 + grp * 128 + kc * 8));
      br1[i] = *reinterpret_cast<const uint4*>(xcb + (unsigned)((64 + rb * 4 + i) * 1536 + 1024 + grp * 128 + kc * 8));
    }
#pragma unroll
    for (int i = 0; i < 2; ++i) {
      xr0[i] = *reinterpret_cast<const uint4*>(xcb + (unsigned)((rx * 2 + i) * 1536 + head * 64 + kx * 8));
      xr1[i] = *reinterpret_cast<const uint4*>(xcb + (unsigned)((64 + rx * 2 + i) * 1536 + head * 64 + kx * 8));
    }
    __syncthreads();
    const float cs_end = csS[127];
    ssd_stage_half(br0, xr0, 0, kc, rb, kx, rx, cs_end, csS, dtS, BTs, xT);
    ssd_stage_half(br1, xr1, 1, kc, rb, kx, rx, cs_end, csS, dtS, BTs, xT);
    __syncthreads();
    f32x16 hacc[2];
    {
      bf16x8 bfr[8], af0[8], af1[8];
      const char* bp = BTs + (32 * wave + l31) * 272 + hh * 16;
      const char* ap = xT + l31 * 272 + hh * 16;
#pragma unroll
      for (int ks = 0; ks < 8; ++ks) {
        bfr[ks] = *reinterpret_cast<const bf16x8*>(bp + ks * 32);
        af0[ks] = *reinterpret_cast<const bf16x8*>(ap + ks * 32);
        af1[ks] = *reinterpret_cast<const bf16x8*>(ap + 32 * 272 + ks * 32);
      }
      __builtin_amdgcn_sched_barrier(0);
#pragma unroll
      for (int pb = 0; pb < 2; ++pb)
#pragma unroll
        for (int i = 0; i < 16; ++i) hacc[pb][i] = 0.f;
#pragma unroll
      for (int ks = 0; ks < 8; ++ks) {
        hacc[0] = MFMA32(af0[ks], bfr[ks], hacc[0]);
        hacc[1] = MFMA32(af1[ks], bfr[ks], hacc[1]);
      }
      __builtin_amdgcn_sched_barrier(0);
    }
    u16* sp = stb + (size_t)item * 8192 + 32 * wave + l31;
#pragma unroll
    for (int pb = 0; pb < 2; ++pb)
#pragma unroll
      for (int i = 0; i < 16; ++i) sp[(pb * 32 + crow(i, hh)) * 128] = f2bf(hacc[pb][i]);
    if (tid == 0) dec[item] = ex2(cs_end * LOG2E_);
    __syncthreads();
  }
}

DI void ssd_scan_phase(const Params& p) {
  u32* stb = reinterpret_cast<u32*>(p.ws + O_HN);
  const float* dec = reinterpret_cast<const float*>(p.ws + O_R + R_DEC);
  const size_t gn = GN_;
  for (size_t u = GT_; u < (size_t)8 * 16 * 4096; u += gn) {
    const int bh = (int)(u >> 12), b = bh >> 4, h = bh & 15, pn2 = (int)u & 4095;
    u32* base = stb + ((size_t)(b * 32) * 16 + h) * 4096 + pn2;
    const float* dbase = dec + (size_t)(b * 32) * 16 + h;
    u32 v[32];
    float d[32];
#pragma unroll
    for (int c = 0; c < 32; ++c) { v[c] = base[(size_t)c * 16 * 4096]; d[c] = dbase[c * 16]; }
    asm volatile("" ::: "memory");
    float r0 = 0.f, r1 = 0.f;
#pragma unroll
    for (int c = 0; c < 32; ++c) {
      base[(size_t)c * 16 * 4096] = pack2(r0, r1);
      r0 = r0 * d[c] + bflo(v[c]);
      r1 = r1 * d[c] + bfhi(v[c]);
    }
  }
}

DI void ssd_out_phase(const Params& p, char* smem) {
  char* R = p.ws + O_R;
  const u16* xc = reinterpret_cast<const u16*>(R + R_XBCC);
  const float* dtb = reinterpret_cast<const float*>(R + R_DT);
  const u16* stb = reinterpret_cast<const u16*>(p.ws + O_HN);
  u16* yb = reinterpret_cast<u16*>(R + R_YCAT1);
  const int tid_ = opaque_tid();
  const int sub = tid_ >> 8;
  smem += sub * 45056;
  const int tid = tid_ & 255, lane = tid & 63, wave = tid >> 6, l31 = lane & 31, hh = lane >> 5;
  char* Bs = smem;
  char* xT = smem + 17408;
  char* Hs = smem + 26624;
  float* csS = reinterpret_cast<float*>(smem + 44032);
  float* dtS = csS + 128;
#pragma unroll 1
  for (int base = blockIdx.x * 2; base < 4096; base += gridDim.x * 2) {
    const int item = base + sub, head = item & 15, grp = head >> 3;
    const size_t t0 = (size_t)(item >> 4) * 128;
    const u16* xcb = xc + (size_t)(unsigned)__builtin_amdgcn_readfirstlane((int)(t0 * 1536));
    const float Aneg = -__expf(reinterpret_cast<const float*>(p.in[20])[head]);
    const float Dsk = reinterpret_cast<const float*>(p.in[21])[head];
    if (wave == 0) ssd_scan_dt(dtb + (size_t)(unsigned)__builtin_amdgcn_readfirstlane((int)(t0 * 16)), head, Aneg, lane, csS, dtS);
    const int lq = 32 * wave + l31;
    bf16x8 cf[8];
    {
      const u16* cp = xcb + (unsigned)(lq * 1536 + 1280 + grp * 128 + hh * 8);
#pragma unroll
      for (int ks = 0; ks < 8; ++ks) cf[ks] = *reinterpret_cast<const bf16x8*>(cp + ks * 16);
    }
    {
      const u16* hsrc = stb + (size_t)(unsigned)__builtin_amdgcn_readfirstlane(item * 8192);
#pragma unroll
      for (int i = 0; i < 4; ++i) {
        const int c = tid + 256 * i, row = c >> 4, kc = c & 15;
        *reinterpret_cast<uint4*>(Hs + row * 272 + kc * 16) = *reinterpret_cast<const uint4*>(hsrc + (unsigned)(row * 128 + kc * 8));
      }
    }
    __syncthreads();
    const float cs_l = csS[lq];
    f32x16 o[2];
    {
      bf16x8 h0[8], h1[8];
      const char* hp = Hs + l31 * 272 + hh * 16;
#pragma unroll
      for (int ks = 0; ks < 8; ++ks) {
        h0[ks] = *reinterpret_cast<const bf16x8*>(hp + ks * 32);
        h1[ks] = *reinterpret_cast<const bf16x8*>(hp + 32 * 272 + ks * 32);
      }
      __builtin_amdgcn_sched_barrier(0);
#pragma unroll
      for (int db = 0; db < 2; ++db)
#pragma unroll
        for (int i = 0; i < 16; ++i) o[db][i] = 0.f;
#pragma unroll
      for (int ks = 0; ks < 8; ++ks) {
        o[0] = MFMA32(h0[ks], cf[ks], o[0]);
        o[1] = MFMA32(h1[ks], cf[ks], o[1]);
      }
      __builtin_amdgcn_sched_barrier(0);
    }
    {
      const float el = ex2(cs_l * LOG2E_);
#pragma unroll
      for (int db = 0; db < 2; ++db)
#pragma unroll
        for (int i = 0; i < 16; ++i) o[db][i] *= el;
    }
#pragma unroll 1
    for (int j = 0; j < 2; ++j) {
      {
        const int kc = tid & 15, rb = tid >> 4;
        const u16* bsrc = xcb + (unsigned)((64 * j + rb * 4) * 1536 + 1024 + grp * 128 + kc * 8);
        const uint4 br0 = *reinterpret_cast<const uint4*>(bsrc);
        const uint4 br1 = *reinterpret_cast<const uint4*>(bsrc + 1536);
        const uint4 br2 = *reinterpret_cast<const uint4*>(bsrc + 2 * 1536);
        const uint4 br3 = *reinterpret_cast<const uint4*>(bsrc + 3 * 1536);
        const int kx = tid & 7, rx = tid >> 3;
        const u16* xsrc = xcb + (unsigned)((64 * j + rx * 2) * 1536 + head * 64 + kx * 8);
        const uint4 xr0 = *reinterpret_cast<const uint4*>(xsrc);
        const uint4 xr1 = *reinterpret_cast<const uint4*>(xsrc + 1536);
        if (j > 0) __syncthreads();
        char* bd = Bs + (rb * 4) * 272 + kc * 16;
        *reinterpret_cast<uint4*>(bd) = br0;
        *reinterpret_cast<uint4*>(bd + 272) = br1;
        *reinterpret_cast<uint4*>(bd + 2 * 272) = br2;
        *reinterpret_cast<uint4*>(bd + 3 * 272) = br3;
        char* xt = xT + (kx * 8) * 144 + rx * 4;
#define SSD_XT(w_, c_)                                                                                  \
  do {                                                                                                 \
    *reinterpret_cast<u32*>(xt + (2 * (w_)) * 144) = (xr0.c_ & 0xffffu) | (xr1.c_ << 16);               \
    *reinterpret_cast<u32*>(xt + (2 * (w_) + 1) * 144) = (xr0.c_ >> 16) | (xr1.c_ & 0xffff0000u);       \
  } while (0)
        SSD_XT(0, x); SSD_XT(1, y); SSD_XT(2, z); SSD_XT(3, w);
#undef SSD_XT
      }
      __syncthreads();
      if (64 * j <= 32 * wave + 31) {
        bf16x8 kf0[8], kf1[8];
        {
          const char* kp = Bs + l31 * 272 + hh * 16;
#pragma unroll
          for (int ks = 0; ks < 8; ++ks) {
            kf0[ks] = *reinterpret_cast<const bf16x8*>(kp + ks * 32);
            kf1[ks] = *reinterpret_cast<const bf16x8*>(kp + 32 * 272 + ks * 32);
          }
        }
        __builtin_amdgcn_sched_barrier(0);
        f32x16 st2[2];
#pragma unroll
        for (int kb = 0; kb < 2; ++kb)
#pragma unroll
          for (int i = 0; i < 16; ++i) st2[kb][i] = 0.f;
#pragma unroll
        for (int ks = 0; ks < 8; ++ks) {
          st2[0] = MFMA32(kf0[ks], cf[ks], st2[0]);
          st2[1] = MFMA32(kf1[ks], cf[ks], st2[1]);
        }
        __builtin_amdgcn_sched_barrier(0);
        uint4 vf[4][2];
#pragma unroll
        for (int s4 = 0; s4 < 4; ++s4)
#pragma unroll
          for (int db = 0; db < 2; ++db) {
            const char* vp = xT + (db * 32 + l31) * 144 + s4 * 32 + hh * 8;
            const uint2 lo = *reinterpret_cast<const uint2*>(vp);
            const uint2 hi = *reinterpret_cast<const uint2*>(vp + 16);
            vf[s4][db] = make_uint4(lo.x, lo.y, hi.x, hi.y);
          }
        __builtin_amdgcn_sched_barrier(0);
#pragma unroll
        for (int kb = 0; kb < 2; ++kb) {
#pragma unroll
          for (int g = 0; g < 4; ++g) {
            const int sb = 64 * j + kb * 32 + 8 * g + 4 * hh;
            const float4 c4 = *reinterpret_cast<const float4*>(csS + sb);
            const float4 d4 = *reinterpret_cast<const float4*>(dtS + sb);
            const float cv[4] = {c4.x, c4.y, c4.z, c4.w};
            const float dv[4] = {d4.x, d4.y, d4.z, d4.w};
#pragma unroll
            for (int e = 0; e < 4; ++e) {
              const int s = sb + e;
              const float v = st2[kb][4 * g + e] * ex2((cs_l - cv[e]) * LOG2E_) * dv[e];
              st2[kb][4 * g + e] = (s <= lq) ? v : 0.f;
            }
          }
#pragma unroll
          for (int s2 = 0; s2 < 2; ++s2) {
            const int s4 = kb * 2 + s2, bse = s2 * 8;
            uint4 pw;
            pw.x = pack2(st2[kb][bse + 0], st2[kb][bse + 1]);
            pw.y = pack2(st2[kb][bse + 2], st2[kb][bse + 3]);
            pw.z = pack2(st2[kb][bse + 4], st2[kb][bse + 5]);
            pw.w = pack2(st2[kb][bse + 6], st2[kb][bse + 7]);
            const bf16x8 pf = as_bf16x8(pw);
#pragma unroll
            for (int db = 0; db < 2; ++db) o[db] = MFMA32(as_bf16x8(vf[s4][db]), pf, o[db]);
          }
        }
      }
    }
    {
      u16* ybb = yb + (size_t)(unsigned)__builtin_amdgcn_readfirstlane((int)(t0 * 1536));
#pragma unroll
      for (int db = 0; db < 2; ++db)
#pragma unroll
        for (int g = 0; g < 4; ++g) {
          const int p0 = db * 32 + 8 * g + 4 * hh;
          const uint2 xv = *reinterpret_cast<const uint2*>(xcb + (unsigned)(lq * 1536 + head * 64 + p0));
          uint2 w;
          w.x = pack2(o[db][4 * g] + Dsk * bflo(xv.x), o[db][4 * g + 1] + Dsk * bfhi(xv.x));
          w.y = pack2(o[db][4 * g + 2] + Dsk * bflo(xv.y), o[db][4 * g + 3] + Dsk * bfhi(xv.y));
          *reinterpret_cast<uint2*>(ybb + (unsigned)(lq * 1536 + head * 64 + p0)) = w;
        }
    }
    __syncthreads();
  }
}

DI void merge_dsw_and_kpe(const Params& p, size_t gtid, size_t gthreads) {
  char* R = p.ws + O_R;
  const float* dsw = reinterpret_cast<const float*>(R + R_DSWO);
  const float* lse = reinterpret_cast<const float*>(R + R_LSE);
  u16* yc = reinterpret_cast<u16*>(p.ws + O_HN);
  const size_t n1 = (size_t)T_ * 64;
  for (size_t it = gtid; it < n1; it += gthreads) {
    const size_t tok = it >> 6;
    const int j = (int)(it >> 4) & 3, dq = (int)it & 15;
    const float l0 = lse[(0 * (size_t)T_ + tok) * 4 + j], l1 = lse[(1 * (size_t)T_ + tok) * 4 + j], l2 = lse[(2 * (size_t)T_ + tok) * 4 + j];
    const float mx = fmaxf(l0, fmaxf(l1, l2));
    const float e0 = __expf(l0 - mx), e1 = __expf(l1 - mx), e2 = __expf(l2 - mx);
    const float inv = 1.f / (e0 + e1 + e2);
    const float4 a = *reinterpret_cast<const float4*>(dsw + ((0 * (size_t)T_ + tok) * 4 + j) * 64 + dq * 4);
    const float4 b = *reinterpret_cast<const float4*>(dsw + ((1 * (size_t)T_ + tok) * 4 + j) * 64 + dq * 4);
    const float4 c = *reinterpret_cast<const float4*>(dsw + ((2 * (size_t)T_ + tok) * 4 + j) * 64 + dq * 4);
    const float w0 = e0 * inv, w1 = e1 * inv, w2 = e2 * inv;
    uint2 o;
    o.x = pack2(w0 * a.x + w1 * b.x + w2 * c.x, w0 * a.y + w1 * b.y + w2 * c.y);
    o.y = pack2(w0 * a.z + w1 * b.z + w2 * c.z, w0 * a.w + w1 * b.w + w2 * c.w);
    *reinterpret_cast<uint2*>(yc + tok * 1024 + j * 64 + dq * 4) = o;
  }
  const u16* cm = reinterpret_cast<const u16*>(R + R_CMLA);
  u16* kpe = reinterpret_cast<u16*>(R + R_KPE);
  const float2* rope = reinterpret_cast<const float2*>(p.ws + O_ROPE);
  const size_t n2 = (size_t)T_ * 16;
  for (size_t it = gtid; it < n2; it += gthreads) {
    const size_t tok = it >> 4;
    const int j = (int)it & 15;
    const float x1 = __uint_as_float((u32)cm[tok * 416 + 384 + j] << 16);
    const float x2 = __uint_as_float((u32)cm[tok * 416 + 384 + 16 + j] << 16);
    const float2 cs = rope[tok * 32 + 2 * j];
    kpe[tok * 32 + j] = f2bf(x1 * cs.x - x2 * cs.y);
    kpe[tok * 32 + 16 + j] = f2bf(x2 * cs.x + x1 * cs.y);
  }
}

DI void mla_row_scales(const Params& p) {
  char* R = p.ws + O_R;
  const u16* cm = reinterpret_cast<const u16*>(R + R_CMLA);
  float* rsq = reinterpret_cast<float*>(R + R_RSQ);
  float* rskv = reinterpret_cast<float*>(R + R_RSKV);
  const int ot = opaque_tid();
  const int lane = ot & 63;
  const int gw = blockIdx.x * (NTHR / 64) + (ot >> 6);
  const int nw = gridDim.x * (NTHR / 64);
  for (int t = gw; t < T_; t += nw) {
    const uint2 a = *reinterpret_cast<const uint2*>(cm + (size_t)t * 416 + lane * 4);
    const u32 b = *reinterpret_cast<const u32*>(cm + (size_t)t * 416 + 256 + lane * 2);
    float sq = bflo(a.x) * bflo(a.x) + bfhi(a.x) * bfhi(a.x) + bflo(a.y) * bflo(a.y) + bfhi(a.y) * bfhi(a.y);
    float sk = bflo(b) * bflo(b) + bfhi(b) * bfhi(b);
    sq = wave_sum(sq);
    sk = wave_sum(sk);
    if (lane == 0) {
      rsq[t] = rsqrtf(sq * (1.f / 256.f) + EPS_);
      rskv[t] = rsqrtf(sk * (1.f / 128.f) + EPS_);
    }
  }
}

DI void ffn_fixup(const Params& p, const float* __restrict__ cw, const float* __restrict__ cb, size_t gtid, size_t gthreads) {
  char* R = p.ws + O_R;
  const float* hg = reinterpret_cast<const float*>(R + R_HEADG);
  const float* hu = reinterpret_cast<const float*>(R + R_HEADU);
  const float* tg = reinterpret_cast<const float*>(R + R_TAILG);
  u16* act = reinterpret_cast<u16*>(R + R_GU);
  for (size_t it = gtid; it < 128ull * 2816; it += gthreads) {
    const int mt = (int)(it / 2816), ch = (int)(it % 2816);
    float t2 = 0.f, t1 = 0.f;
    if ((mt & 15) != 0) { t2 = tg[((size_t)(mt - 1) * 2) * 2816 + ch]; t1 = tg[((size_t)(mt - 1) * 2 + 1) * 2816 + ch]; }
    const float g0 = hg[((size_t)mt * 2) * 2816 + ch], g1 = hg[((size_t)mt * 2 + 1) * 2816 + ch];
    const float u0 = hu[((size_t)mt * 2) * 2816 + ch], u1 = hu[((size_t)mt * 2 + 1) * 2816 + ch];
    const float b = cb[ch], w0 = cw[ch], w1 = cw[2816 + ch], w2 = cw[2 * 2816 + ch];
    act[((size_t)mt * 256) * 2816 + ch] = f2bf(siluf(b + w0 * t2 + w1 * t1 + w2 * g0) * u0);
    act[((size_t)mt * 256 + 1) * 2816 + ch] = f2bf(siluf(b + w0 * t1 + w1 * g0 + w2 * g1) * u1);
  }
}

DI void ssm_fixup(const Params& p, size_t gtid, size_t gthreads) {
  char* R = p.ws + O_R;
  const float* hx = reinterpret_cast<const float*>(R + R_HEADX);
  const float* tx = reinterpret_cast<const float*>(R + R_TAILX);
  u16* xo = reinterpret_cast<u16*>(R + R_XBCC);
  const float* cw = reinterpret_cast<const float*>(p.in[17]);
  const float* cb = reinterpret_cast<const float*>(p.in[18]);
  for (size_t it = gtid; it < 128ull * 1536; it += gthreads) {
    const int mt = (int)(it / 1536), ch = (int)(it % 1536);
    float t3 = 0.f, t2 = 0.f, t1 = 0.f;
    if ((mt & 15) != 0) {
      const float* t = tx + ((size_t)(mt - 1) * 3) * 1536 + ch;
      t3 = t[0]; t2 = t[1536]; t1 = t[2 * 1536];
    }
    const float* h = hx + ((size_t)mt * 3) * 1536 + ch;
    const float g0 = h[0], g1 = h[1536], g2 = h[2 * 1536];
    const float b = cb[ch], w0 = cw[ch], w1 = cw[1536 + ch], w2 = cw[2 * 1536 + ch], w3 = cw[3 * 1536 + ch];
    u16* o = xo + ((size_t)mt * 256) * 1536 + ch;
    o[0] = f2bf(siluf(b + w0 * t3 + w1 * t2 + w2 * t1 + w3 * g0));
    o[1536] = f2bf(siluf(b + w0 * t2 + w1 * t1 + w2 * g0 + w3 * g1));
    o[2 * 1536] = f2bf(siluf(b + w0 * t1 + w1 * g0 + w2 * g1 + w3 * g2));
  }
}

DI void ssm_gate_norm(const Params& p) {
  char* R = p.ws + O_R;
  u16* yb = reinterpret_cast<u16*>(R + R_YCAT1);
  const u16* zb = reinterpret_cast<const u16*>(R + R_Z);
  const float* gn = reinterpret_cast<const float*>(p.in[22]);
  const int ot = opaque_tid();
  const int lane = ot & 63;
  const int gw = blockIdx.x * (NTHR / 64) + (ot >> 6);
  const int nw = gridDim.x * (NTHR / 64);
  constexpr int U = 4;
  for (int it0 = gw; it0 < T_ * 2; it0 += nw * U) {
    uint4 yv[U], zv[U];
#pragma unroll
    for (int u = 0; u < U; ++u) {
      const int it = (it0 + u * nw < T_ * 2) ? it0 + u * nw : it0;
      const size_t t = it >> 1;
      const int g = it & 1;
      yv[u] = *reinterpret_cast<const uint4*>(yb + t * 1536 + g * 512 + lane * 8);
      zv[u] = *reinterpret_cast<const uint4*>(zb + t * 1024 + g * 512 + lane * 8);
    }
    asm volatile("" ::: "memory");
#pragma unroll
    for (int u = 0; u < U; ++u) {
      const int it = it0 + u * nw;
      const size_t t = it >> 1;
      const int g = it & 1;
      float y[8], z[8];
      unpack8(yv[u], y);
      unpack8(zv[u], z);
      float ss = 0.f;
#pragma unroll
      for (int e = 0; e < 8; ++e) { y[e] *= siluf(z[e]); ss += y[e] * y[e]; }
      ss = wave_sum(ss);
      const float sc = rsqrtf(ss * (1.f / 512.f) + EPS_);
      const float* gp = gn + g * 512 + lane * 8;
      uint4 o;
      o.x = pack2(y[0] * sc * gp[0], y[1] * sc * gp[1]); o.y = pack2(y[2] * sc * gp[2], y[3] * sc * gp[3]);
      o.z = pack2(y[4] * sc * gp[4], y[5] * sc * gp[5]); o.w = pack2(y[6] * sc * gp[6], y[7] * sc * gp[7]);
      if (it < T_ * 2) *reinterpret_cast<uint4*>(yb + t * 1536 + g * 512 + lane * 8) = o;
    }
  }
}

DI void grid_barrier(unsigned* ctr, unsigned& epoch) {
  asm volatile("s_waitcnt vmcnt(0)" ::: "memory");
  __syncthreads();
  epoch += 1;
  if (threadIdx.x == 0) {
    __builtin_amdgcn_fence(__ATOMIC_RELEASE, "agent");
    asm volatile("s_waitcnt vmcnt(0)" ::: "memory");
    __hip_atomic_fetch_add(ctr, 1u, __ATOMIC_RELAXED, __HIP_MEMORY_SCOPE_AGENT);
    const unsigned target = epoch * gridDim.x;
    while (__hip_atomic_load(ctr, __ATOMIC_RELAXED, __HIP_MEMORY_SCOPE_AGENT) < target) __builtin_amdgcn_s_sleep(1);
    __builtin_amdgcn_fence(__ATOMIC_ACQUIRE, "agent");
    asm volatile("s_waitcnt vmcnt(0)" ::: "memory");
  }
  __syncthreads();
}

__global__ void __launch_bounds__(NTHR, 2) fwd_megakernel(Params p) {
  extern __shared__ __attribute__((aligned(16))) char smem[];
  cg::grid_group grid = cg::this_grid();
  unsigned* bar = reinterpret_cast<unsigned*>(p.ws + WS_BAR);
  unsigned epoch = 0;
  float* ssq = reinterpret_cast<float*>(p.ws + WS_SS);
  u16* xb1 = reinterpret_cast<u16*>(p.out);
  char* ws = p.ws;
  char* R = ws + O_R;
  auto F = [&](int i) { return reinterpret_cast<const float*>(p.in[i]); };
  auto W16 = [&](size_t off) { return reinterpret_cast<u16*>(ws + off); };
  u16* hn = W16(O_HN);

#pragma unroll 1
  for (int job = 0; job < 12; ++job) {
    const float* W; u16* Wt; int K, N, Npad, cmode = 0; const float* gain = nullptr;
    switch (job) {
      case 0: W = F(3); Wt = W16(O_WIN0); K = 1024; N = 2720; Npad = 2816; cmode = 1; break;
      case 1: W = F(5); Wt = W16(O_WUQ); K = 256; N = 1152; Npad = 1280; cmode = 2; gain = F(4); break;
      case 2: W = F(7); Wt = W16(O_WUKV); K = 128; N = 1536; Npad = 1536; gain = F(6); break;
      case 3: W = F(8); Wt = W16(O_WOUT0); K = 1024; N = 1024; Npad = 1024; break;
      case 4: cvt_weight_gu(F(10), F(11), W16(O_WGU0), F(9), GT_, GN_); continue;
      case 5: cvt_weight_gu(F(25), F(26), W16(O_WGU1), F(24), GT_, GN_); continue;
      case 6: W = F(14); Wt = W16(O_WDN0); K = 2816; N = 1024; Npad = 1024; break;
      case 7: W = F(16); Wt = W16(O_WIN1); K = 1024; N = 4112; Npad = 4352; gain = F(15); break;
      case 8: W = F(23); Wt = W16(O_WOUT1); K = 1536; N = 1024; Npad = 1024; break;
      case 9: continue;
      case 10: continue;
      default: W = F(29); Wt = W16(O_WDN1); K = 2816; N = 1024; Npad = 1024; break;
    }
    cvt_weight(W, Wt, K, N, Npad, cmode, gain, GT_, GN_);
  }
  {
    float2* rope = reinterpret_cast<float2*>(ws + O_ROPE);
    const int* pos = reinterpret_cast<const int*>(p.in[1]);
    const size_t gn = GN_;
    for (size_t it = GT_; it < (size_t)T_ * 32; it += gn) {
      const int i = (int)it & 31;
      const float inv = 1.0f / powf(10000.f, (float)i * (2.0f / 64.f));
      const float ang = (float)pos[it >> 5] * inv;
      float sn, cs;
      sincosf(ang, &sn, &cs);
      rope[it] = make_float2(cs, sn);
    }
  }
  rmsnorm_rows<false>(F(0), F(2), hn);
  grid.sync();

  { GemmDesc d{hn, 1024, W16(O_WIN0), 1024, 11, nullptr, nullptr, nullptr, nullptr, nullptr}; gemm_phase<EPI_IN0>(p, d, smem); }
  grid_barrier(bar, epoch);
  mla_row_scales(p);
  attn_phase<1>(p, smem);
  grid_barrier(bar, epoch);
  merge_dsw_and_kpe(p, GT_, GN_);
  {
    const u16* cm = reinterpret_cast<const u16*>(R + R_CMLA);
    GemmDesc dq{cm, 416, W16(O_WUQ), 256, 5, nullptr, nullptr, nullptr, nullptr, nullptr};
    gemm_phase<EPI_UQ>(p, dq, smem);
    GemmDesc dk{cm + 256, 416, W16(O_WUKV), 128, 6, nullptr, nullptr, nullptr, nullptr, nullptr};
    gemm_phase<EPI_UKV>(p, dk, smem);
  }
  grid_barrier(bar, epoch);
  attn_phase<0>(p, smem);
  grid_barrier(bar, epoch);
  { GemmDesc d{hn, 1024, W16(O_WOUT0), 1024, 4, F(0), nullptr, nullptr, reinterpret_cast<u16*>(R + R_XB0), ssq}; gemm_phase<EPI_RES>(p, d, smem); }
  grid_barrier(bar, epoch);
  { GemmDesc d{reinterpret_cast<const u16*>(R + R_XB0), 1024, W16(O_WGU0), 1024, 22, F(12), const_cast<float*>(F(13)), nullptr, nullptr, ssq}; gemm_phase<EPI_GU>(p, d, smem); }
  grid_barrier(bar, epoch);
  ffn_fixup(p, F(12), F(13), GT_, GN_);
  grid_barrier(bar, epoch);
  {
    const u16* act = reinterpret_cast<const u16*>(R + R_GU);
    GemmDesc d{act, 2816, W16(O_WDN0), 2816, 4, nullptr, nullptr, reinterpret_cast<const u16*>(R + R_XB0), xb1, ssq + 4 * T_};
    gemm_phase<EPI_RES>(p, d, smem);
  }
  grid_barrier(bar, epoch);
  { GemmDesc d{xb1, 1024, W16(O_WIN1), 1024, 17, nullptr, nullptr, nullptr, nullptr, ssq + 4 * T_}; gemm_phase<EPI_IN1>(p, d, smem); }
  grid_barrier(bar, epoch);
  ssm_fixup(p, GT_, GN_);
  grid_barrier(bar, epoch);
  ssd_states_phase(p, smem);
  attn_phase<2>(p, smem);
  grid_barrier(bar, epoch);
  ssd_scan_phase(p);
  grid_barrier(bar, epoch);
  ssd_out_phase(p, smem);
  grid_barrier(bar, epoch);
  ssm_gate_norm(p);
  grid_barrier(bar, epoch);
  {
    const u16* yc1 = reinterpret_cast<const u16*>(R + R_YCAT1);
    GemmDesc d{yc1, 1536, W16(O_WOUT1), 1536, 4, nullptr, nullptr, xb1, hn, ssq + 8 * T_};
    gemm_phase<EPI_RES>(p, d, smem);
  }
  grid_barrier(bar, epoch);
  { GemmDesc d{hn, 1024, W16(O_WGU1), 1024, 22, F(27), const_cast<float*>(F(28)), nullptr, nullptr, ssq + 8 * T_}; gemm_phase<EPI_GU>(p, d, smem); }
  grid_barrier(bar, epoch);
  ffn_fixup(p, F(27), F(28), GT_, GN_);
  grid_barrier(bar, epoch);
  {
    const u16* act = reinterpret_cast<const u16*>(R + R_GU);
    GemmDesc d{act, 2816, W16(O_WDN1), 2816, 4, nullptr, p.out, hn, nullptr, nullptr};
    gemm_phase<EPI_RES>(p, d, smem);
  }
  grid_barrier(bar, epoch);
  rmsnorm_rows<true>(p.out, F(30), p.out);
}

extern "C" void kernel_launch(void* const* d_in, const int* in_sizes, int n_in, void* d_out, int out_size,
                              void* d_ws, size_t ws_size, hipStream_t stream) {
  static int grid_blocks = 0;
  if (!grid_blocks) {
    int dev = 0, cus = 0, per_cu = 0;
    hipGetDevice(&dev);
    hipDeviceGetAttribute(&cus, hipDeviceAttributeMultiprocessorCount, dev);
    hipFuncSetAttribute(reinterpret_cast<const void*>(fwd_megakernel), hipFuncAttributeMaxDynamicSharedMemorySize, SMEM_BYTES);
    hipOccupancyMaxActiveBlocksPerMultiprocessor(&per_cu, fwd_megakernel, NTHR, SMEM_BYTES);
    if (per_cu > 1) per_cu = 1;
    if (per_cu < 1) per_cu = 1;
    grid_blocks = cus * per_cu;
  }
  if (ws_size < WS_NEED) fprintf(stderr, "workspace too small: %zu < %zu\n", ws_size, (size_t)WS_NEED);
  Params p{};
  for (int i = 0; i < 31; ++i) p.in[i] = d_in[i];
  p.out = reinterpret_cast<float*>(d_out);
  p.ws = reinterpret_cast<char*>(d_ws);
  hipMemsetAsync(reinterpret_cast<char*>(d_ws) + WS_BAR, 0, 256, stream);
  void* args[] = {&p};
  hipError_t e = hipLaunchCooperativeKernel(reinterpret_cast<void*>(fwd_megakernel), dim3(grid_blocks), dim3(NTHR), args, SMEM_BYTES, stream);
  if (e != hipSuccess) fprintf(stderr, "cooperative launch failed: %s (grid %d)\n", hipGetErrorString(e), grid_blocks);
}
```

```cpp
#include <hip/hip_runtime.h>
#include <hip/hip_bf16.h>
#include <hip/hip_cooperative_groups.h>
#include <cstdio>
namespace cg = cooperative_groups;

typedef unsigned short u16;
typedef unsigned int u32;
using bf16x8 = __attribute__((ext_vector_type(8))) short;
using f32x16 = __attribute__((ext_vector_type(16))) float;
#define MFMA32(a, b, c) __builtin_amdgcn_mfma_f32_32x32x16_bf16((a), (b), (c), 0, 0, 0)
#define DI __device__ __forceinline__

constexpr int T_ = 32768;
constexpr int SEQ_ = 4096;
constexpr float EPS_ = 1e-6f;
constexpr float LOG2E_ = 1.4426950408889634f;
constexpr float LN2_ = 0.6931471805599453f;

constexpr size_t SZ_WIN0 = 2816ull * 1024 * 2;
constexpr size_t SZ_WUQ = 1280ull * 256 * 2;
constexpr size_t SZ_WUKV = 1536ull * 128 * 2;
constexpr size_t SZ_WOUT0 = 1024ull * 1024 * 2;
constexpr size_t SZ_WGU = 5632ull * 1024 * 2;
constexpr size_t SZ_WDN = 1024ull * 2816 * 2;
constexpr size_t SZ_WIN1 = 4352ull * 1024 * 2;
constexpr size_t SZ_WOUT1 = 1024ull * 1536 * 2;
constexpr size_t O_WIN0 = 0;
constexpr size_t O_WUQ = O_WIN0 + SZ_WIN0;
constexpr size_t O_WUKV = O_WUQ + SZ_WUQ;
constexpr size_t O_WOUT0 = O_WUKV + SZ_WUKV;
constexpr size_t O_WGU0 = O_WOUT0 + SZ_WOUT0;
constexpr size_t O_WDN0 = O_WGU0 + SZ_WGU;
constexpr size_t O_WIN1 = O_WDN0 + SZ_WDN;
constexpr size_t O_WOUT1 = O_WIN1 + SZ_WIN1;
constexpr size_t O_WGU1 = O_WOUT1 + SZ_WOUT1;
constexpr size_t O_WDN1 = O_WGU1 + SZ_WGU;
constexpr size_t O_ROPE = O_WDN1 + SZ_WDN;
constexpr size_t O_HN = O_ROPE + (size_t)T_ * 32 * 8;
constexpr size_t O_R = O_HN + (size_t)T_ * 1024 * 2;
constexpr size_t R_QKV0 = 0;
constexpr size_t R_QMLA = 0;
constexpr size_t R_KMLA = R_QMLA + (size_t)T_ * 1152 * 2;
constexpr size_t R_CMLA = R_QKV0 + (size_t)T_ * 2304 * 2;
constexpr size_t R_DSWO = R_CMLA + (size_t)T_ * 416 * 2;
constexpr size_t R_LSE = R_DSWO + 3ull * T_ * 256 * 4;
constexpr size_t R_KPE = R_LSE + 3ull * T_ * 4 * 4;
constexpr size_t R_VMLA = R_KPE + (size_t)T_ * 32 * 2;
constexpr size_t R_RSQ = R_VMLA + (size_t)T_ * 768 * 2;
constexpr size_t R_RSKV = R_RSQ + (size_t)T_ * 4;
constexpr size_t R_END0 = R_RSKV + (size_t)T_ * 4;
constexpr size_t R_GU = 0;
constexpr size_t R_XB0 = 200ull << 20;
constexpr size_t R_HEADG = (size_t)T_ * 2816 * 2;
constexpr size_t R_HEADU = R_HEADG + 128ull * 2 * 2816 * 4;
constexpr size_t R_TAILG = R_HEADU + 128ull * 2 * 2816 * 4;
constexpr size_t R_ENDF = R_TAILG + 128ull * 2 * 2816 * 4;
constexpr size_t R_Z = 0;
constexpr size_t R_XBCR = R_Z + (size_t)T_ * 1024 * 2;
constexpr size_t R_YCAT1 = R_XBCR;
constexpr size_t R_QKV1 = R_XBCR + (size_t)T_ * 1536 * 2;
constexpr size_t R_XBCC = R_QKV1 + (size_t)T_ * 1536 * 2;
constexpr size_t R_DT = R_XBCC + (size_t)T_ * 1536 * 2;
constexpr size_t R_DEC = R_DT + (size_t)T_ * 16 * 4;
constexpr size_t R_HEADX = R_DEC + 4096 * 4;
constexpr size_t R_TAILX = R_HEADX + 128ull * 3 * 1536 * 4;
constexpr size_t R_END1 = R_TAILX + 128ull * 3 * 1536 * 4;
constexpr size_t R_SIZE = (R_END1 > R_ENDF ? (R_END1 > R_END0 ? R_END1 : R_END0) : (R_ENDF > R_END0 ? R_ENDF : R_END0));
constexpr size_t WS_BAR = O_R + R_SIZE;
constexpr size_t WS_SS = WS_BAR + 256;
constexpr size_t WS_NEED = WS_SS + 3ull * T_ * 16;
static_assert(R_KMLA + (size_t)T_ * 768 * 2 <= R_CMLA, "mla alias overflow");
static_assert(WS_NEED <= 536870912ull, "workspace too large");
static_assert(R_XB0 >= R_DSWO && R_XB0 + (size_t)T_ * 1024 * 2 <= R_LSE, "xb0 must sit inside the (dead) dsw output buffer");

constexpr int SMEM_BYTES = 131072 + 4096;
constexpr int NTHR = 512;

struct Params {
  const void* in[31];
  float* out;
  char* ws;
};

typedef __attribute__((ext_vector_type(2))) __bf16 bf16x2_t;
typedef __attribute__((ext_vector_type(2))) float f32x2_t;
DI u32 pack2(float a, float b) {
  const f32x2_t v = {a, b};
  return __builtin_bit_cast(u32, __builtin_convertvector(v, bf16x2_t));
}
DI u32 pack2_old(float a, float b) {
  __hip_bfloat162 y = __float22bfloat162_rn(make_float2(a, b));
  return *reinterpret_cast<u32*>(&y);
}
DI u16 f2bf(float a) {
  __hip_bfloat16 y = __float2bfloat16(a);
  return *reinterpret_cast<u16*>(&y);
}
DI float bflo(u32 w) { return __uint_as_float(w << 16); }
DI float bfhi(u32 w) { return __uint_as_float(w & 0xffff0000u); }
DI float ex2(float x) { return __builtin_amdgcn_exp2f(x); }
DI float lg2(float x) { return __builtin_amdgcn_logf(x); }
DI float siluf(float v) { return v * __builtin_amdgcn_rcpf(1.f + ex2(-v * LOG2E_)); }
DI int crow(int i, int h) { return (i & 3) + 8 * (i >> 2) + 4 * h; }
DI bf16x8 as_bf16x8(uint4 v) { return __builtin_bit_cast(bf16x8, v); }
DI void unpack8(uint4 v, float* f) {
  f[0] = bflo(v.x); f[1] = bfhi(v.x); f[2] = bflo(v.y); f[3] = bfhi(v.y);
  f[4] = bflo(v.z); f[5] = bfhi(v.z); f[6] = bflo(v.w); f[7] = bfhi(v.w);
}
DI int opaque_tid() { int t = threadIdx.x; asm volatile("" : "+v"(t)); return t; }
#define GT_ ((size_t)blockIdx.x * NTHR + opaque_tid())
#define GN_ ((size_t)gridDim.x * NTHR)
DI float wave_sum(float v) {
#pragma unroll
  for (int o = 32; o >= 1; o >>= 1) v += __shfl_xor(v, o);
  return v;
}

DI int colmap(int n, int cmode) {
  const int cb = n & ~31, u = n & 31, nb = u >> 4, fr = u & 15;
  if (cmode == 1 && n < 1536) return (n & ~63) + ((n >> 5) & 1) * 16 + fr + 32 * nb;
  if (cmode == 2 && ((cb % 96) >> 5) == 2) return n;
  return cb + 2 * fr + nb;
}
DI void cvt_weight(const float* __restrict__ W, u16* __restrict__ Wt, int K, int N, int Npad, int cmode,
                   const float* __restrict__ gain, size_t gtid, size_t gthreads) {
  const size_t items = (size_t)Npad * (K >> 3);
  for (size_t it = gtid; it < items; it += gthreads) {
    const int n = (int)(it % Npad);
    const int kc = (int)(it / Npad);
    const int lc = colmap(n, cmode);
    float v[8];
#pragma unroll
    for (int j = 0; j < 8; ++j) {
      const int k = kc * 8 + j;
      float w = (lc < N) ? W[(size_t)k * N + lc] : 0.f;
      if (gain) w *= gain[k];
      v[j] = w;
    }
    uint4 o;
    o.x = pack2(v[0], v[1]); o.y = pack2(v[2], v[3]); o.z = pack2(v[4], v[5]); o.w = pack2(v[6], v[7]);
    *reinterpret_cast<uint4*>(Wt + (size_t)n * K + kc * 8) = o;
  }
}

DI void cvt_weight_gu(const float* __restrict__ Wg, const float* __restrict__ Wu, u16* __restrict__ Wt, const float* __restrict__ gain,
                      size_t gtid, size_t gthreads) {
  const size_t items = 5632ull * 128;
  for (size_t it = gtid; it < items; it += gthreads) {
    const int n = (int)(it % 5632);
    const int kc = (int)(it / 5632);
    const int pn = n >> 8, bj = (n >> 7) & 1, wc = (n >> 5) & 3, nb = (n >> 4) & 1, fr = n & 15;
    const int ch = pn * 128 + (wc * 16 + fr) * 2 + bj;
    const float* W = nb ? Wu : Wg;
    float v[8];
#pragma unroll
    for (int j = 0; j < 8; ++j) v[j] = W[(size_t)(kc * 8 + j) * 2816 + ch] * gain[kc * 8 + j];
    uint4 o;
    o.x = pack2(v[0], v[1]); o.y = pack2(v[2], v[3]); o.z = pack2(v[4], v[5]); o.w = pack2(v[6], v[7]);
    *reinterpret_cast<uint4*>(Wt + (size_t)n * 1024 + kc * 8) = o;
  }
}

template <bool OUTF32>
DI void rmsnorm_rows(const float* src, const float* __restrict__ g, void* dst) {
  const int ot = opaque_tid();
  const int lane = ot & 63;
  const int gw = blockIdx.x * (NTHR / 64) + (ot >> 6);
  const int nw = gridDim.x * (NTHR / 64);
  constexpr int U = 4;
  float4 g4[4];
#pragma unroll
  for (int i = 0; i < 4; ++i) g4[i] = reinterpret_cast<const float4*>(g)[lane + 64 * i];
  for (int row0 = gw; row0 < T_; row0 += nw * U) {
    float4 v[U][4];
#pragma unroll
    for (int u = 0; u < U; ++u) {
      const int row = row0 + u * nw;
      const float4* s = reinterpret_cast<const float4*>(src + (size_t)(row < T_ ? row : row0) * 1024);
#pragma unroll
      for (int i = 0; i < 4; ++i) v[u][i] = s[lane + 64 * i];
    }
    asm volatile("" ::: "memory");
#pragma unroll
    for (int u = 0; u < U; ++u) {
      const int row = row0 + u * nw;
      float ss = 0.f;
#pragma unroll
      for (int i = 0; i < 4; ++i) ss += v[u][i].x * v[u][i].x + v[u][i].y * v[u][i].y + v[u][i].z * v[u][i].z + v[u][i].w * v[u][i].w;
      ss = wave_sum(ss);
      const float sc = rsqrtf(ss * (1.f / 1024.f) + EPS_);
      if (row < T_) {
#pragma unroll
        for (int i = 0; i < 4; ++i) {
          const float a = v[u][i].x * sc * g4[i].x, b = v[u][i].y * sc * g4[i].y, c = v[u][i].z * sc * g4[i].z, d = v[u][i].w * sc * g4[i].w;
          if (OUTF32) {
            reinterpret_cast<float4*>(reinterpret_cast<float*>(dst) + (size_t)row * 1024)[lane + 64 * i] = make_float4(a, b, c, d);
          } else {
            uint2 o;
            o.x = pack2(a, b); o.y = pack2(c, d);
            reinterpret_cast<uint2*>(reinterpret_cast<u16*>(dst) + (size_t)row * 1024)[lane + 64 * i] = o;
          }
        }
      }
    }
  }
}

enum { EPI_IN0 = 0, EPI_UQ, EPI_UKV, EPI_RES, EPI_GU, EPI_IN1 };
using f32x4 = __attribute__((ext_vector_type(4))) float;

struct GemmDesc {
  const u16* A; int lda;
  const u16* Bt; int K; int nN;
  const float* res; float* dst;
  const u16* res16;
  u16* xb; float* ss;
};

DI const char* uniform_ptr(const void* q) {
  const unsigned long long v = (unsigned long long)q;
  const unsigned lo = __builtin_amdgcn_readfirstlane((unsigned)v), hi = __builtin_amdgcn_readfirstlane((unsigned)(v >> 32));
  return reinterpret_cast<const char*>(((unsigned long long)hi << 32) | lo);
}
DI int lds_byte(int r, int c) {
  const int st = (r >> 4) * 2 + (c >> 5), rr = r & 15, cc = c & 31, ob = rr * 64 + cc * 2;
  return st * 1024 + (ob ^ (((ob >> 9) & 1) << 5));
}
DI void stage_rc(int b, int& Rr, int& Cc) {
  const int st = b / 1024, sb = b % 1024, swz = sb ^ (((sb >> 9) & 1) << 5);
  Rr = (st >> 1) * 16 + swz / 64;
  Cc = (st & 1) * 32 + (swz % 64) / 2;
}

template <int EPI>
DI void gemm_store(const Params& p, const GemmDesc& d, int row, int cb, int fr, float v0, float v1, float2 cs, float s) {
  char* R = p.ws + O_R;
  if (EPI == EPI_IN0) {
    u16* qkv = reinterpret_cast<u16*>(R + R_QKV0);
    if (cb < 1536) {
      const int dd = ((cb >> 5) & 1) * 16 + fr;
      u16* o = qkv + (size_t)row * 2304 + (cb & ~63) + dd;
      o[0] = f2bf(v0 * cs.x - v1 * cs.y);
      o[32] = f2bf(v1 * cs.x + v0 * cs.y);
    } else {
      const int c0 = cb + 2 * fr;
      if (c0 < 2304) *reinterpret_cast<u32*>(qkv + (size_t)row * 2304 + c0) = pack2_old(v0, v1);
      else if (c0 < 2720) *reinterpret_cast<u32*>(reinterpret_cast<u16*>(R + R_CMLA) + (size_t)row * 416 + (c0 - 2304)) = pack2_old(v0, v1);
    }
  } else if (EPI == EPI_UQ) {
    if (cb < 1152) {
      u16* qm = reinterpret_cast<u16*>(R + R_QMLA);
      v0 *= s; v1 *= s;
      if (((cb % 96) >> 5) == 2) {
        qm[(size_t)row * 1152 + cb + fr] = f2bf(v0 * cs.x - v1 * cs.y);
        qm[(size_t)row * 1152 + cb + 16 + fr] = f2bf(v1 * cs.x + v0 * cs.y);
      } else {
        *reinterpret_cast<u32*>(qm + (size_t)row * 1152 + cb + 2 * fr) = pack2_old(v0, v1);
      }
    }
  } else if (EPI == EPI_UKV) {
    const int c0 = cb + 2 * fr, head = c0 >> 7, w = c0 & 127;
    u16* dp = (w < 64) ? (reinterpret_cast<u16*>(R + R_KMLA) + head * 64 + w) : (reinterpret_cast<u16*>(R + R_VMLA) + head * 64 + (w - 64));
    *reinterpret_cast<u32*>(dp + (size_t)row * 768) = pack2_old(v0 * s, v1 * s);
  }
}

DI void gemm_tile_coords(int L, int nwg, int nN, int& brow, int& bcol) {
  int wgid = L;
  const int q = nwg / 8, r = nwg % 8, xcd = wgid % 8, off = wgid / 8;
  wgid = (xcd < r ? xcd * (q + 1) : r * (q + 1) + (xcd - r) * q) + off;
  const int nig = 8 * nN, gid = wgid / nig, fm = gid * 8;
  const int pm = fm + ((wgid % nig) % 8), pn = (wgid % nig) / 8;
  brow = pm * 256; bcol = pn * 256;
}

template <int EPI>
DI void gemm_phase(const Params& p, const GemmDesc d, char* smem) {
  constexpr int BK = 64, HALF = 128, HT = HALF * BK;
  u16* shm = reinterpret_cast<u16*>(smem);
  const float* rs = reinterpret_cast<const float*>(p.ws + O_R + (EPI == EPI_UQ ? R_RSQ : R_RSKV));
  int tid_ = threadIdx.x;
  asm volatile("" : "+v"(tid_));
  const int tid = tid_;
  const int wid = tid >> 6, lane = tid & 63, wr = wid >> 2, wc = wid & 3, fr = lane & 15, fq = lane >> 4;
  const int K = d.K, lda = d.lda, nt = K / BK;
  const u16* A = d.A;
  const u16* Bt = d.Bt;
  const int nM = 128, nN = d.nN, nwg = nM * nN;
  constexpr int AH = (EPI == EPI_GU || EPI == EPI_IN1) ? 16 : 128;
  const int wbase = __builtin_amdgcn_readfirstlane(tid >> 6) * 1024;
  unsigned voA0, voA1, voB0, voB1;
  {
    int r0, c0, r1, c1;
    stage_rc(tid * 16, r0, c0);
    stage_rc(tid * 16 + 8192, r1, c1);
    const int pr0 = (EPI == EPI_GU || EPI == EPI_IN1) ? (((r0 >> 6) * 4 + ((r0 >> 2) & 3)) * 32 + ((r0 >> 4) & 3) * 4 + (r0 & 3)) : r0;
    const int pr1 = (EPI == EPI_GU || EPI == EPI_IN1) ? (((r1 >> 6) * 4 + ((r1 >> 2) & 3)) * 32 + ((r1 >> 4) & 3) * 4 + (r1 & 3)) : r1;
    voA0 = (unsigned)(pr0 * lda + c0) * 2u; voA1 = (unsigned)(pr1 * lda + c1) * 2u;
    voB0 = (unsigned)(r0 * K + c0) * 2u; voB1 = (unsigned)(r1 * K + c1) * 2u;
  }
#define SA(b, h) (shm + ((b) * 2 + (h)) * HT)
#define SB(b, h) (shm + (4 + (b) * 2 + (h)) * HT)
#define STAGE(P, BASE, LD, br, kt, VO0, VO1)                                                         \
  do {                                                                                               \
    const char* _sb = uniform_ptr((BASE) + (long)(br) * (LD) + (long)(kt) * BK);                     \
    __builtin_amdgcn_global_load_lds((const unsigned*)(_sb + (VO0)), (unsigned*)((char*)(P) + wbase), 16, 0, 0);        \
    __builtin_amdgcn_global_load_lds((const unsigned*)(_sb + (VO1)), (unsigned*)((char*)(P) + wbase + 8192), 16, 0, 0); \
  } while (0)
#define STA(P, br, kt) STAGE(P, A, lda, br, kt, voA0, voA1)
#define STB(P, br, kt) STAGE(P, Bt, K, br, kt, voB0, voB1)
#define LDA(dst, b, h)                                                                               \
  for (int m = 0; m < 4; ++m)                                                                        \
    for (int k = 0; k < 2; ++k)                                                                      \
      dst[m][k] = *reinterpret_cast<const bf16x8*>((char*)SA(b, h) + lds_byte(wr * 64 + m * 16 + fr, k * 32 + fq * 8))
#define LDB(dst, b, h)                                                                               \
  for (int n = 0; n < 2; ++n)                                                                        \
    for (int k = 0; k < 2; ++k)                                                                      \
      dst[n][k] = *reinterpret_cast<const bf16x8*>((char*)SB(b, h) + lds_byte(wc * 32 + n * 16 + fr, k * 32 + fq * 8))
#define MMA(ai, bj, At_, Bt_)                                                                        \
  do {                                                                                               \
    __builtin_amdgcn_s_setprio(1);                                                                   \
    for (int m = 0; m < 4; ++m)                                                                      \
      for (int n = 0; n < 2; ++n)                                                                    \
        for (int k = 0; k < 2; ++k)                                                                  \
          acc[ai][bj][m][n] = __builtin_amdgcn_mfma_f32_16x16x32_bf16(At_[m][k], Bt_[n][k], acc[ai][bj][m][n], 0, 0, 0); \
    __builtin_amdgcn_s_setprio(0);                                                                   \
  } while (0)
#define WAIT_V(n) asm volatile("s_waitcnt vmcnt(" #n ")" ::: "memory")
#define WAIT_L(n) asm volatile("s_waitcnt lgkmcnt(" #n ")" ::: "memory")
#define BAR __builtin_amdgcn_s_barrier()
#define SCHED __builtin_amdgcn_sched_barrier(0)

  int brow = 0, bcol = 0;
  if ((int)blockIdx.x < nwg) {
    gemm_tile_coords(blockIdx.x, nwg, nN, brow, bcol);
    STB(SB(0, 0), bcol, 0); STA(SA(0, 0), brow, 0);
    STB(SB(0, 1), bcol + HALF, 0); STA(SA(0, 1), brow + AH, 0);
  }
#pragma unroll 1
  for (int L = blockIdx.x; L < nwg; L += gridDim.x) {
    f32x4 acc[2][2][4][2];
#pragma unroll
    for (int a = 0; a < 2; ++a)
#pragma unroll
      for (int b = 0; b < 2; ++b)
#pragma unroll
        for (int m = 0; m < 4; ++m)
#pragma unroll
          for (int n = 0; n < 2; ++n) acc[a][b][m][n] = f32x4{0.f, 0.f, 0.f, 0.f};
    bf16x8 At[4][2], B0[2][2], B1[2][2];

    if (wr == 1) BAR;
    WAIT_V(0); BAR;
    STB(SB(1, 0), bcol, 1); STA(SA(1, 0), brow, 1); STB(SB(1, 1), bcol + HALF, 1);
    WAIT_V(6); BAR;
#pragma unroll 1
    for (int t = 0; t < nt - 2; t += 2) {
      LDB(B0, 0, 0); SCHED; LDA(At, 0, 0); STA(SA(1, 1), brow + AH, t + 1);
      WAIT_L(8); BAR; WAIT_L(0); MMA(0, 0, At, B0); BAR; SCHED;
      LDB(B1, 0, 1); STB(SB(0, 0), bcol, t + 2);
      BAR; WAIT_L(0); MMA(0, 1, At, B1); BAR;
      LDA(At, 0, 1); STA(SA(0, 0), brow, t + 2);
      BAR; WAIT_L(0); MMA(1, 0, At, B0); BAR; SCHED;
      STB(SB(0, 1), bcol + HALF, t + 2);
      WAIT_V(6); BAR; MMA(1, 1, At, B1); BAR;
      LDB(B0, 1, 0); SCHED; LDA(At, 1, 0); STA(SA(0, 1), brow + AH, t + 2);
      WAIT_L(8); BAR; WAIT_L(0); MMA(0, 0, At, B0); BAR; SCHED;
      LDB(B1, 1, 1); STB(SB(1, 0), bcol, t + 3);
      BAR; WAIT_L(0); MMA(0, 1, At, B1); BAR;
      LDA(At, 1, 1); STA(SA(1, 0), brow, t + 3);
      BAR; WAIT_L(0); MMA(1, 0, At, B0); BAR; SCHED;
      STB(SB(1, 1), bcol + HALF, t + 3);
      WAIT_V(6); BAR; MMA(1, 1, At, B1); BAR;
    }
    {
      LDB(B0, 0, 0); LDA(At, 0, 0); STA(SA(1, 1), brow + AH, nt - 1);
      BAR; WAIT_L(0); MMA(0, 0, At, B0); BAR;
      LDB(B1, 0, 1); BAR; WAIT_L(0); MMA(0, 1, At, B1); BAR;
      LDA(At, 0, 1); WAIT_V(4); BAR; WAIT_L(0); MMA(1, 0, At, B0); MMA(1, 1, At, B1); BAR;
    }
    {
      LDB(B0, 1, 0); LDA(At, 1, 0); WAIT_V(2); BAR; WAIT_L(0); MMA(0, 0, At, B0); BAR;
      LDB(B1, 1, 1); WAIT_V(0); BAR; WAIT_L(0); MMA(0, 1, At, B1); BAR;
      LDA(At, 1, 1); BAR; WAIT_L(0); MMA(1, 0, At, B0); MMA(1, 1, At, B1); BAR;
    }
    if (wr == 0) BAR;
    const int crow0 = brow, ccol0 = bcol;
    if (L + (int)gridDim.x < nwg) {
      gemm_tile_coords(L + gridDim.x, nwg, nN, brow, bcol);
      STB(SB(0, 0), bcol, 0); STA(SA(0, 0), brow, 0);
      STB(SB(0, 1), bcol + HALF, 0); STA(SA(0, 1), brow + AH, 0);
    }
    {
      const int t2 = opaque_tid();
      const int wid2 = t2 >> 6, ln2 = t2 & 63, wr2 = wid2 >> 2, wc2 = wid2 & 3, fr2 = ln2 & 15, fq2 = ln2 >> 4;
      if (EPI == EPI_GU || EPI == EPI_IN1) {
        float* sS = reinterpret_cast<float*>(smem + 131072) + 768;
        if (t2 < 256) {
          const float4 q4 = reinterpret_cast<const float4*>(d.ss)[crow0 + t2];
          sS[t2] = rsqrtf((q4.x + q4.y + q4.z + q4.w) * (1.f / 1024.f) + EPS_);
        }
        __syncthreads();
        const float* sp = sS + (wr2 * 4 + fq2) * 32;
#pragma unroll
        for (int ai = 0; ai < 2; ++ai)
#pragma unroll
          for (int m = 0; m < 4; ++m) {
            const float4 s4 = *reinterpret_cast<const float4*>(sp + ai * 16 + m * 4);
            const float sv[4] = {s4.x, s4.y, s4.z, s4.w};
#pragma unroll
            for (int j = 0; j < 4; ++j)
#pragma unroll
              for (int bj = 0; bj < 2; ++bj) { acc[ai][bj][m][0][j] *= sv[j]; acc[ai][bj][m][1][j] *= sv[j]; }
          }
      }
      if (EPI == EPI_RES) {
#pragma unroll
        for (int ai = 0; ai < 2; ++ai) {
          float2 xin[4][4][2];
#pragma unroll
          for (int m = 0; m < 4; ++m)
#pragma unroll
            for (int j = 0; j < 4; ++j)
#pragma unroll
              for (int bj = 0; bj < 2; ++bj) {
                const size_t idx = (size_t)(crow0 + ai * HALF + wr2 * 64 + m * 16 + fq2 * 4 + j) * 1024 + ccol0 + bj * HALF + wc2 * 32 + 2 * fr2;
                if (d.res16) {
                  const u32 w = *reinterpret_cast<const u32*>(d.res16 + idx);
                  xin[m][j][bj] = make_float2(bflo(w), bfhi(w));
                } else {
                  xin[m][j][bj] = *reinterpret_cast<const float2*>(d.res + idx);
                }
              }
          asm volatile("" ::: "memory");
#pragma unroll
          for (int m = 0; m < 4; ++m)
#pragma unroll
            for (int j = 0; j < 4; ++j) {
              const int row = crow0 + ai * HALF + wr2 * 64 + m * 16 + fq2 * 4 + j;
              float sq = 0.f;
#pragma unroll
              for (int bj = 0; bj < 2; ++bj) {
                const size_t idx = (size_t)row * 1024 + ccol0 + bj * HALF + wc2 * 32 + 2 * fr2;
                float x0 = xin[m][j][bj].x + acc[ai][bj][m][0][j], x1 = xin[m][j][bj].y + acc[ai][bj][m][1][j];
                if (d.dst) *reinterpret_cast<float2*>(d.dst + idx) = make_float2(x0, x1);
                if (d.xb) {
                  const u32 w = pack2(x0, x1);
                  *reinterpret_cast<u32*>(d.xb + idx) = w;
                  x0 = bflo(w); x1 = bfhi(w);
                }
                sq += x0 * x0 + x1 * x1;
              }
              if (d.ss) {
                sq += __shfl_xor(sq, 1); sq += __shfl_xor(sq, 2); sq += __shfl_xor(sq, 4); sq += __shfl_xor(sq, 8);
                if (fr2 == 0) reinterpret_cast<float*>(smem + 131072)[wc2 * 256 + (row - crow0)] = sq;
              }
            }
        }
        if (d.ss) {
          __syncthreads();
          if (t2 < 256) {
            const float* e = reinterpret_cast<const float*>(smem + 131072) + t2;
            d.ss[(size_t)(crow0 + t2) * 4 + (ccol0 >> 8)] = e[0] + e[256] + e[512] + e[768];
          }
        }
      } else if (EPI == EPI_IN1) {
        char* R = p.ws + O_R;
        float* ex = reinterpret_cast<float*>(smem + 131072);
        const int mt = crow0 >> 8;
        const int tk0 = crow0 + (wr2 * 4 + fq2) * 32;
        const bool has_x = (ccol0 + 256 > 1024) && (ccol0 < 2560);
        if (has_x) {
          if (wr2 == 0 && fq2 == 3) {
#pragma unroll
            for (int bj = 0; bj < 2; ++bj)
#pragma unroll
              for (int nb = 0; nb < 2; ++nb)
#pragma unroll
                for (int r = 0; r < 3; ++r) ex[((((bj * 4 + wc2) * 16 + fr2) * 2 + nb) * 3) + r] = acc[1][bj][3][nb][1 + r];
          }
          __syncthreads();
        }
        const bool tile_head = (wr2 == 0 && fq2 == 0);
#pragma unroll
        for (int bj = 0; bj < 2; ++bj) {
          const int c0 = ccol0 + bj * HALF + wc2 * 32 + 2 * fr2;
          if (c0 < 1024) {
            u16* zp = reinterpret_cast<u16*>(R + R_Z) + (size_t)tk0 * 1024 + c0;
#pragma unroll
            for (int ai = 0; ai < 2; ++ai)
#pragma unroll
              for (int m = 0; m < 4; ++m)
#pragma unroll
                for (int j = 0; j < 4; ++j)
                  *reinterpret_cast<u32*>(zp + (size_t)(ai * 16 + m * 4 + j) * 1024) = pack2(acc[ai][bj][m][0][j], acc[ai][bj][m][1][j]);
          } else if (c0 < 2560) {
            const int xcn = c0 - 1024;
            const float* cw = reinterpret_cast<const float*>(p.in[17]);
            const float* cbias = reinterpret_cast<const float*>(p.in[18]);
            float ov[2][32];
#pragma unroll
            for (int nb = 0; nb < 2; ++nb) {
              const int ch = xcn + nb;
              const float b = cbias[ch], w0 = cw[ch], w1 = cw[1536 + ch], w2 = cw[2 * 1536 + ch], w3 = cw[3 * 1536 + ch];
              float g3 = __shfl(acc[1][bj][3][nb][1], (ln2 - 16) & 63);
              float g2 = __shfl(acc[1][bj][3][nb][2], (ln2 - 16) & 63);
              float g1 = __shfl(acc[1][bj][3][nb][3], (ln2 - 16) & 63);
              if (wr2 == 1 && fq2 == 0) {
                const float* e = ex + ((((bj * 4 + wc2) * 16 + fr2) * 2 + nb) * 3);
                g3 = e[0]; g2 = e[1]; g1 = e[2];
              }
              if (tile_head) {
                float* hx = reinterpret_cast<float*>(R + R_HEADX) + ((size_t)mt * 3) * 1536 + ch;
                hx[0] = acc[0][bj][0][nb][0]; hx[1536] = acc[0][bj][0][nb][1]; hx[2 * 1536] = acc[0][bj][0][nb][2];
              }
              if (wr2 == 1 && fq2 == 3) {
                float* tx = reinterpret_cast<float*>(R + R_TAILX) + ((size_t)mt * 3) * 1536 + ch;
                tx[0] = acc[1][bj][3][nb][1]; tx[1536] = acc[1][bj][3][nb][2]; tx[2 * 1536] = acc[1][bj][3][nb][3];
              }
#pragma unroll
              for (int ai = 0; ai < 2; ++ai)
#pragma unroll
                for (int m = 0; m < 4; ++m)
#pragma unroll
                  for (int j = 0; j < 4; ++j) {
                    const float g = acc[ai][bj][m][nb][j];
                    ov[nb][ai * 16 + m * 4 + j] = siluf(b + w0 * g3 + w1 * g2 + w2 * g1 + w3 * g);
                    g3 = g2; g2 = g1; g1 = g;
                  }
            }
            u16* xp = reinterpret_cast<u16*>(R + R_XBCC) + (size_t)tk0 * 1536 + xcn;
#pragma unroll
            for (int k = 0; k < 32; ++k)
              if (!(tile_head && k < 3)) *reinterpret_cast<u32*>(xp + (size_t)k * 1536) = pack2(ov[0][k], ov[1][k]);
          } else if (c0 < 2576) {
            const float* dt_bias = reinterpret_cast<const float*>(p.in[19]);
            const float b0 = dt_bias[c0 - 2560], b1 = dt_bias[c0 - 2559];
            float* dp = reinterpret_cast<float*>(R + R_DT) + (size_t)tk0 * 16 + (c0 - 2560);
#pragma unroll
            for (int ai = 0; ai < 2; ++ai)
#pragma unroll
              for (int m = 0; m < 4; ++m)
#pragma unroll
                for (int j = 0; j < 4; ++j) {
                  const float u0 = acc[ai][bj][m][0][j] + b0, u1 = acc[ai][bj][m][1][j] + b1;
                  float* q = dp + (size_t)(ai * 16 + m * 4 + j) * 16;
                  q[0] = fmaxf(u0, 0.f) + LN2_ * lg2(1.f + ex2(-fabsf(u0) * LOG2E_));
                  q[1] = fmaxf(u1, 0.f) + LN2_ * lg2(1.f + ex2(-fabsf(u1) * LOG2E_));
                }
          } else if (c0 < 4112) {
            u16* qp = reinterpret_cast<u16*>(R + R_QKV1) + (size_t)tk0 * 1536 + (c0 - 2576);
#pragma unroll
            for (int ai = 0; ai < 2; ++ai)
#pragma unroll
              for (int m = 0; m < 4; ++m)
#pragma unroll
                for (int j = 0; j < 4; ++j)
                  *reinterpret_cast<u32*>(qp + (size_t)(ai * 16 + m * 4 + j) * 1536) = pack2(acc[ai][bj][m][0][j], acc[ai][bj][m][1][j]);
          }
        }
      } else if (EPI == EPI_GU) {
        char* R = p.ws + O_R;
        const float* cw = d.res;
        const float* cbias = d.dst;
        float* ex = reinterpret_cast<float*>(smem + 131072);
        const int mt = crow0 >> 8;
        const int tk0 = crow0 + (wr2 * 4 + fq2) * 32;
        const int ch0 = (ccol0 >> 8) * 128 + (wc2 * 16 + fr2) * 2;
        if (wr2 == 0 && fq2 == 3) {
#pragma unroll
          for (int bj = 0; bj < 2; ++bj) {
            ex[((bj * 4 + wc2) * 16 + fr2) * 2] = acc[1][bj][3][0][2];
            ex[((bj * 4 + wc2) * 16 + fr2) * 2 + 1] = acc[1][bj][3][0][3];
          }
        }
        __syncthreads();
        const bool tile_head = (wr2 == 0 && fq2 == 0);
        u16* actp = reinterpret_cast<u16*>(R + R_GU) + (size_t)tk0 * 2816 + ch0;
        float a_out[2][32];
#pragma unroll
        for (int bj = 0; bj < 2; ++bj) {
          const int ch = ch0 + bj;
          const float b = cbias[ch], w0 = cw[ch], w1 = cw[2816 + ch], w2 = cw[2 * 2816 + ch];
          float gm1 = __shfl(acc[1][bj][3][0][3], (ln2 - 16) & 63);
          float gm2 = __shfl(acc[1][bj][3][0][2], (ln2 - 16) & 63);
          if (wr2 == 1 && fq2 == 0) {
            gm2 = ex[((bj * 4 + wc2) * 16 + fr2) * 2];
            gm1 = ex[((bj * 4 + wc2) * 16 + fr2) * 2 + 1];
          }
          if (tile_head) {
            float* hg = reinterpret_cast<float*>(R + R_HEADG) + ((size_t)mt * 2) * 2816 + ch;
            float* hu = reinterpret_cast<float*>(R + R_HEADU) + ((size_t)mt * 2) * 2816 + ch;
            hg[0] = acc[0][bj][0][0][0]; hg[2816] = acc[0][bj][0][0][1];
            hu[0] = acc[0][bj][0][1][0]; hu[2816] = acc[0][bj][0][1][1];
          }
          if (wr2 == 1 && fq2 == 3) {
            float* tg = reinterpret_cast<float*>(R + R_TAILG) + ((size_t)mt * 2) * 2816 + ch;
            tg[0] = acc[1][bj][3][0][2]; tg[2816] = acc[1][bj][3][0][3];
          }
#pragma unroll
          for (int ai = 0; ai < 2; ++ai)
#pragma unroll
            for (int m = 0; m < 4; ++m)
#pragma unroll
              for (int j = 0; j < 4; ++j) {
                const float g = acc[ai][bj][m][0][j];
                const float v = b + w0 * gm2 + w1 * gm1 + w2 * g;
                a_out[bj][ai * 16 + m * 4 + j] = siluf(v) * acc[ai][bj][m][1][j];
                gm2 = gm1; gm1 = g;
              }
        }
#pragma unroll
        for (int k = 0; k < 32; ++k)
          if (!(tile_head && k < 2))
            *reinterpret_cast<u32*>(actp + (size_t)k * 2816) = pack2(a_out[0][k], a_out[1][k]);
      } else {
#pragma unroll
        for (int ai = 0; ai < 2; ++ai) {
          float2 csr[4][4];
          float rsr[4][4];
#pragma unroll
          for (int m = 0; m < 4; ++m)
#pragma unroll
            for (int j = 0; j < 4; ++j) {
              const int row = crow0 + ai * HALF + wr2 * 64 + m * 16 + fq2 * 4 + j;
              csr[m][j] = make_float2(1.f, 0.f);
              rsr[m][j] = 1.f;
              if (EPI == EPI_IN0) csr[m][j] = reinterpret_cast<const float2*>(p.ws + O_ROPE)[(size_t)row * 32 + (wc2 & 1) * 16 + fr2];
              if (EPI == EPI_UQ) csr[m][j] = reinterpret_cast<const float2*>(p.ws + O_ROPE)[(size_t)row * 32 + 2 * fr2];
              if (EPI == EPI_UQ || EPI == EPI_UKV) rsr[m][j] = rs[row];
            }
          asm volatile("" ::: "memory");
#pragma unroll
          for (int bj = 0; bj < 2; ++bj)
#pragma unroll
            for (int m = 0; m < 4; ++m)
#pragma unroll
              for (int j = 0; j < 4; ++j)
                gemm_store<EPI>(p, d, crow0 + ai * HALF + wr2 * 64 + m * 16 + fq2 * 4 + j, ccol0 + bj * HALF + wc2 * 32, fr2,
                                acc[ai][bj][m][0][j], acc[ai][bj][m][1][j], csr[m][j], rsr[m][j]);
        }
      }
    }
  }
#undef SA
#undef SB
#undef STAGE
#undef STA
#undef STB
#undef LDA
#undef LDB
#undef MMA
}

template <int MODE>
DI void attn_phase(const Params& p, char* smem) {
  constexpr int DK = (MODE == 0) ? 96 : 64;
  constexpr int NKS = DK / 16;
  constexpr int KSTR = (DK + 8) * 2;
  constexpr int NKCH = DK / 8;
  constexpr int VSTR = 136;
  constexpr int STG = 64 * KSTR + 64 * VSTR;
  char* R = p.ws + O_R;
  int tid_ = threadIdx.x;
  asm volatile("" : "+v"(tid_));
  const int tid = tid_, lane = tid & 63, wave = tid >> 6, l31 = lane & 31, hh = lane >> 5;
  const int nitems = (MODE == 2) ? 1024 : 1536;
  for (int L = blockIdx.x; L < nitems; L += gridDim.x) {
    int b, head, qb, dil = 1, rr = 0, grp = 0, jh = 0;
    if (MODE == 0) {
      const int rnd = L / (int)gridDim.x, pos = L % (int)gridDim.x;
      const bool whole = (nitems % (int)gridDim.x) == 0;
      const int idx = (whole && (rnd & 1)) ? (rnd * (int)gridDim.x + (int)gridDim.x - 1 - pos) : L;
      qb = 15 - idx / 96; const int bh = idx % 96; b = bh / 12; head = bh % 12;
    }
    else if (MODE == 2) { qb = 15 - L / 64; const int bh = L % 64; b = bh >> 3; head = bh & 7; }
    else {
      b = L / 192; const int r1 = L % 192; grp = r1 >> 6; const int r2 = r1 & 63; jh = r2 >> 4; const int u = r2 & 15;
      dil = (grp == 0) ? 1 : (grp == 1 ? 4 : 16);
      rr = u % dil; qb = u / dil; head = grp * 4 + jh;
    }
    const size_t tokb = (size_t)b * SEQ_;
    const u16 *Qb, *Kb, *Vb, *K2b = nullptr;
    size_t qstr, kstr;
    if (MODE == 0) {
      Qb = reinterpret_cast<const u16*>(R + R_QMLA) + tokb * 1152 + head * 96; qstr = 1152;
      Kb = reinterpret_cast<const u16*>(R + R_KMLA) + tokb * 768 + head * 64; kstr = 768;
      Vb = reinterpret_cast<const u16*>(R + R_VMLA) + tokb * 768 + head * 64;
      K2b = reinterpret_cast<const u16*>(R + R_KPE) + tokb * 32;
    } else if (MODE == 1) {
      Qb = reinterpret_cast<const u16*>(R + R_QKV0) + (tokb + rr) * 2304 + head * 64; qstr = (size_t)dil * 2304;
      Kb = Qb + 768; Vb = Qb + 1536; kstr = qstr;
    } else {
      Qb = reinterpret_cast<const u16*>(R + R_QKV1) + tokb * 1536 + head * 64; qstr = 1536;
      Kb = Qb + 512; Vb = Qb + 1024; kstr = 1536;
    }
    int first, step, count;
    if (MODE == 0) { first = 0; step = 64; count = 4 * qb + 4; }
    else if (MODE == 1) { first = (qb == 0) ? 0 : 256 * qb - 128; step = 64; count = (qb == 0) ? 4 : 6; }
    else { first = 64 * (4 * qb + 3); step = -64; count = 4 * qb + 4; }
    const int iq0 = 256 * qb + 32 * wave;
    const int iq = iq0 + l31;

    bf16x8 qf[NKS];
    {
      const u16* qp = Qb + (size_t)iq * qstr + hh * 8;
#pragma unroll
      for (int ks = 0; ks < NKS; ++ks) qf[ks] = *reinterpret_cast<const bf16x8*>(qp + ks * 16);
    }
    f32x16 o[2];
#pragma unroll
    for (int db = 0; db < 2; ++db)
#pragma unroll
      for (int i = 0; i < 16; ++i) o[db][i] = 0.f;
    float m_run = -1e30f, l_run = 0.f, Rsum = 0.f;

    uint4 kreg0, kreg1 = make_uint4(0, 0, 0, 0), vreg0 = make_uint4(0, 0, 0, 0), vreg1 = make_uint4(0, 0, 0, 0);
#define ATT_GLOAD(ik0_)                                                                               \
  do {                                                                                               \
    {                                                                                                \
      const int row_ = tid / NKCH, kc_ = tid % NKCH;                                                 \
      const size_t ik_ = (size_t)((ik0_) + row_);                                                    \
      const u16* s_;                                                                                 \
      if (MODE == 0) s_ = (kc_ < 8) ? (Kb + ik_ * 768 + kc_ * 8) : (K2b + ik_ * 32 + (kc_ - 8) * 8);  \
      else s_ = Kb + ik_ * kstr + kc_ * 8;                                                           \
      kreg0 = *reinterpret_cast<const uint4*>(s_);                                                   \
    }                                                                                                \
    if (MODE == 0 && tid < 256) {                                                                    \
      const int c_ = tid + 512, row_ = c_ / NKCH, kc_ = c_ % NKCH;                                   \
      const size_t ik_ = (size_t)((ik0_) + row_);                                                    \
      const u16* s_ = (kc_ < 8) ? (Kb + ik_ * 768 + kc_ * 8) : (K2b + ik_ * 32 + (kc_ - 8) * 8);      \
      kreg1 = *reinterpret_cast<const uint4*>(s_);                                                   \
    }                                                                                                \
    if (tid < 256) {                                                                                 \
      const int kg_ = tid & 31, dg_ = tid >> 5;                                                      \
      vreg0 = *reinterpret_cast<const uint4*>(Vb + (size_t)((ik0_) + 2 * kg_) * kstr + dg_ * 8);     \
      vreg1 = *reinterpret_cast<const uint4*>(Vb + (size_t)((ik0_) + 2 * kg_ + 1) * kstr + dg_ * 8); \
    }                                                                                                \
  } while (0)
#define ATT_VW(w_, av_, cv_)                                                                          \
  do {                                                                                               \
    *reinterpret_cast<u32*>(VtW + (dg_ * 8 + 2 * (w_)) * VSTR + kg_ * 4) = ((av_) & 0xffffu) | ((cv_) << 16);          \
    *reinterpret_cast<u32*>(VtW + (dg_ * 8 + 2 * (w_) + 1) * VSTR + kg_ * 4) = ((av_) >> 16) | ((cv_) & 0xffff0000u);  \
  } while (0)
#define ATT_SWRITE()                                                                                  \
  do {                                                                                               \
    *reinterpret_cast<uint4*>(KsW + (tid / NKCH) * KSTR + (tid % NKCH) * 16) = kreg0;                 \
    if (MODE == 0 && tid < 256)                                                                      \
      *reinterpret_cast<uint4*>(KsW + ((tid + 512) / NKCH) * KSTR + ((tid + 512) % NKCH) * 16) = kreg1; \
    if (tid < 256) {                                                                                 \
      const int kg_ = tid & 31, dg_ = tid >> 5;                                                      \
      ATT_VW(0, vreg0.x, vreg1.x); ATT_VW(1, vreg0.y, vreg1.y);                                      \
      ATT_VW(2, vreg0.z, vreg1.z); ATT_VW(3, vreg0.w, vreg1.w);                                      \
    }                                                                                                \
  } while (0)
    volatile int* flg = reinterpret_cast<volatile int*>(smem + 49152);
    ATT_GLOAD(first);
    __syncthreads();
    {
      char* KsW = smem; char* VtW = smem + 64 * KSTR;
      ATT_SWRITE();
      if (MODE == 2 && tid == 0) { flg[0] = 1; flg[1] = 1; }
    }
    __syncthreads();
    for (int j = 0; j < count; ++j) {
      const int ik0 = first + j * step;
      const char* Ks = smem + (j & 1) * STG;
      const char* Vt = Ks + 64 * KSTR;
      if (MODE == 2) {
        if (j > 0 && flg[(j - 1) % 3] != 0) break;
        if (tid == 0) flg[(j + 1) % 3] = 1;
      }
      if (j + 1 < count) ATT_GLOAD(ik0 + step);

      bool skip;
      if (MODE == 0) skip = ik0 > iq0 + 31;
      else if (MODE == 1) skip = (ik0 > iq0 + 31) || (ik0 + 63 < iq0 - 128);
      else skip = ik0 >= iq0 + 31;
      if (skip) {
        if (MODE == 2) flg[j % 3] = 0;
      } else {
      f32x16 st[2];
      bf16x8 kf[2][NKS];
#pragma unroll
      for (int kb = 0; kb < 2; ++kb) {
        const char* kp = Ks + (kb * 32 + l31) * KSTR + hh * 16;
#pragma unroll
        for (int ks = 0; ks < NKS; ++ks) kf[kb][ks] = *reinterpret_cast<const bf16x8*>(kp + ks * 32);
      }
      __builtin_amdgcn_sched_barrier(0);
#pragma unroll
      for (int kb = 0; kb < 2; ++kb)
#pragma unroll
        for (int i = 0; i < 16; ++i) st[kb][i] = 0.f;
#pragma unroll
      for (int ks = 0; ks < NKS; ++ks) {
        st[0] = MFMA32(kf[0][ks], qf[ks], st[0]);
        st[1] = MFMA32(kf[1][ks], qf[ks], st[1]);
      }
      __builtin_amdgcn_sched_barrier(0);
      uint4 vf[4][2];
#pragma unroll
      for (int s4 = 0; s4 < 4; ++s4)
#pragma unroll
        for (int db = 0; db < 2; ++db) {
          const char* vp = Vt + (db * 32 + l31) * VSTR + s4 * 32 + hh * 8;
          const uint2 lo = *reinterpret_cast<const uint2*>(vp);
          const uint2 hi = *reinterpret_cast<const uint2*>(vp + 16);
          vf[s4][db] = make_uint4(lo.x, lo.y, hi.x, hi.y);
        }
      __builtin_amdgcn_sched_barrier(0);

      if (MODE != 2) {
        const float sc = ((MODE == 0) ? 0.10206207261596577f : 0.125f) * LOG2E_;
        const bool need_mask = (MODE == 1) || (__builtin_amdgcn_readfirstlane((int)(ik0 + 63 > iq0)) != 0);
        if (need_mask) {
#pragma unroll
          for (int kb = 0; kb < 2; ++kb)
#pragma unroll
            for (int i = 0; i < 16; ++i) {
              const int ik = ik0 + kb * 32 + crow(i, hh);
              bool valid = ik <= iq;
              if (MODE == 1) valid = valid && (iq - ik <= 128);
              st[kb][i] = valid ? st[kb][i] : -1e30f;
            }
          asm volatile("" ::: "memory");
        }
        float mxr = -1e30f;
#pragma unroll
        for (int kb = 0; kb < 2; ++kb)
#pragma unroll
          for (int i = 0; i < 16; ++i) mxr = fmaxf(mxr, st[kb][i]);
        float mx = fmaxf(m_run, (mxr > -1e29f) ? mxr * sc : -1e30f);
        mx = fmaxf(mx, __shfl_xor(mx, 32));
        const float alpha = ex2(m_run - mx);
        m_run = mx;
        float ps = 0.f;
#pragma unroll
        for (int kb = 0; kb < 2; ++kb)
#pragma unroll
          for (int i = 0; i < 16; ++i) {
            const float v = st[kb][i];
            const float pv = (MODE == 0 || v > -1e29f) ? ex2(fmaf(v, sc, -mx)) : 0.f;
            st[kb][i] = pv;
            ps += pv;
          }
        l_run = l_run * alpha + ps;
        if (!__all(alpha == 1.f)) {
#pragma unroll
          for (int db = 0; db < 2; ++db)
#pragma unroll
            for (int i = 0; i < 16; ++i) o[db][i] *= alpha;
        }
      } else {
        float own[8], par[8];
        float lsv[2][16];
#pragma unroll
        for (int kb = 0; kb < 2; ++kb)
#pragma unroll
          for (int g = 0; g < 4; ++g) {
            float gs = 0.f;
#pragma unroll
            for (int e = 0; e < 4; ++e) {
              const int i = g * 4 + e;
              const int ik = ik0 + kb * 32 + crow(i, hh);
              const float z = st[kb][i] * 0.125f;
              const float sp = fmaxf(z, 0.f) + LN2_ * lg2(1.f + ex2(-fabsf(z) * LOG2E_));
              const bool valid = ik < iq;
              const float ls = valid ? -sp : 0.f;
              lsv[kb][i] = ls;
              st[kb][i] = valid ? (z + ls) : -1e30f;
              gs += ls;
            }
            own[kb * 4 + g] = gs;
          }
#pragma unroll
        for (int a = 0; a < 8; ++a) par[a] = __shfl_xor(own[a], 32);
        float run = 0.f, sg[8];
#pragma unroll
        for (int a = 7; a >= 0; --a) {
          const float g_odd = hh ? own[a] : par[a];
          const float g_even = hh ? par[a] : own[a];
          const float sg_odd = run; run += g_odd;
          const float sg_even = run; run += g_even;
          sg[a] = hh ? sg_odd : sg_even;
        }
#pragma unroll
        for (int kb = 0; kb < 2; ++kb)
#pragma unroll
          for (int g = 0; g < 4; ++g) {
            float aft = Rsum + sg[kb * 4 + g];
#pragma unroll
            for (int e = 3; e >= 0; --e) {
              const int i = g * 4 + e;
              const float u = st[kb][i];
              st[kb][i] = (u > -1e29f) ? ex2((u + aft) * LOG2E_) : 0.f;
              aft += lsv[kb][i];
            }
          }
        Rsum += run;
      }

#pragma unroll
      for (int s4 = 0; s4 < 4; ++s4) {
        const int kb = s4 >> 1, base = (s4 & 1) * 8;
        uint4 pw;
        pw.x = pack2(st[kb][base + 0], st[kb][base + 1]);
        pw.y = pack2(st[kb][base + 2], st[kb][base + 3]);
        pw.z = pack2(st[kb][base + 4], st[kb][base + 5]);
        pw.w = pack2(st[kb][base + 6], st[kb][base + 7]);
        const bf16x8 pf = as_bf16x8(pw);
#pragma unroll
        for (int db = 0; db < 2; ++db) o[db] = MFMA32(as_bf16x8(vf[s4][db]), pf, o[db]);
      }
      if (MODE == 2) {
        if (!(Rsum < -104.f)) flg[j % 3] = 0;
      }
      }
      if (j + 1 < count) {
        char* KsW = smem + ((j + 1) & 1) * STG; char* VtW = KsW + 64 * KSTR;
        ATT_SWRITE();
      }
      __syncthreads();
    }

    float inv = 1.f;
    if (MODE != 2) {
      const float lt = l_run + __shfl_xor(l_run, 32);
      inv = 1.f / lt;
      if (MODE == 1 && hh == 0) {
        float* lse = reinterpret_cast<float*>(R + R_LSE);
        const size_t tok = tokb + (size_t)iq * dil + rr;
        lse[((size_t)grp * T_ + tok) * 4 + jh] = LN2_ * (m_run + lg2(lt));
      }
    }
    if (MODE == 1) {
      float* dst = reinterpret_cast<float*>(R + R_DSWO);
      const size_t tok = tokb + (size_t)iq * dil + rr;
      float* dp = dst + (((size_t)grp * T_ + tok) * 4 + jh) * 64;
#pragma unroll
      for (int db = 0; db < 2; ++db)
#pragma unroll
        for (int g = 0; g < 4; ++g) {
          const int d0 = db * 32 + 8 * g + 4 * hh;
          *reinterpret_cast<float4*>(dp + d0) =
              make_float4(o[db][4 * g] * inv, o[db][4 * g + 1] * inv, o[db][4 * g + 2] * inv, o[db][4 * g + 3] * inv);
        }
    } else {
      u16* dp;
      if (MODE == 0) dp = reinterpret_cast<u16*>(p.ws + O_HN) + (tokb + iq) * 1024 + 256 + head * 64;
      else dp = reinterpret_cast<u16*>(R + R_YCAT1) + (tokb + iq) * 1536 + 1024 + head * 64;
#pragma unroll
      for (int db = 0; db < 2; ++db)
#pragma unroll
        for (int g = 0; g < 4; ++g) {
          const int d0 = db * 32 + 8 * g + 4 * hh;
          uint2 w;
          w.x = pack2(o[db][4 * g] * inv, o[db][4 * g + 1] * inv);
          w.y = pack2(o[db][4 * g + 2] * inv, o[db][4 * g + 3] * inv);
          *reinterpret_cast<uint2*>(dp + d0) = w;
        }
    }
  }
}

DI void ssd_scan_dt(const float* dtc, int head, float Aneg, int lane, float* csS, float* dtS) {
  const float d0 = dtc[(unsigned)(2 * lane * 16 + head)], d1 = dtc[(unsigned)((2 * lane + 1) * 16 + head)];
  const float a0 = d0 * Aneg, a1 = d1 * Aneg;
  float s = a0 + a1;
#pragma unroll
  for (int off = 1; off < 64; off <<= 1) {
    const float v = __shfl_up(s, off);
    if (lane >= off) s += v;
  }
  csS[2 * lane] = s - a1; csS[2 * lane + 1] = s;
  dtS[2 * lane] = d0; dtS[2 * lane + 1] = d1;
}

DI void ssd_stage_half(const uint4 (&br)[4], const uint4 (&xr)[2], int h2, int kc, int rb, int kx, int rx, float cs_end,
                       const float* csS, const float* dtS, char* BTs, char* xT) {
  float w0, w1, w2, w3;
  {
    const int s = 64 * h2 + rb * 4;
    w0 = dtS[s] * ex2((cs_end - csS[s]) * LOG2E_);
    w1 = dtS[s + 1] * ex2((cs_end - csS[s + 1]) * LOG2E_);
    w2 = dtS[s + 2] * ex2((cs_end - csS[s + 2]) * LOG2E_);
    w3 = dtS[s + 3] * ex2((cs_end - csS[s + 3]) * LOG2E_);
  }
  char* bt = BTs + (kc * 8) * 272 + (64 * h2 + rb * 4) * 2;
#define SSD_BT(e_, c_, f_)                                                                              \
  do {                                                                                                 \
    uint2 w_;                                                                                          \
    w_.x = pack2(f_(br[0].c_) * w0, f_(br[1].c_) * w1);                                                 \
    w_.y = pack2(f_(br[2].c_) * w2, f_(br[3].c_) * w3);                                                 \
    *reinterpret_cast<uint2*>(bt + (e_) * 272) = w_;                                                   \
  } while (0)
  SSD_BT(0, x, bflo); SSD_BT(1, x, bfhi); SSD_BT(2, y, bflo); SSD_BT(3, y, bfhi);
  SSD_BT(4, z, bflo); SSD_BT(5, z, bfhi); SSD_BT(6, w, bflo); SSD_BT(7, w, bfhi);
#undef SSD_BT
  char* xt = xT + (kx * 8) * 272 + (64 * h2 + rx * 2) * 2;
#define SSD_XT(w_, c_)                                                                                  \
  do {                                                                                                 \
    *reinterpret_cast<u32*>(xt + (2 * (w_)) * 272) = (xr[0].c_ & 0xffffu) | (xr[1].c_ << 16);           \
    *reinterpret_cast<u32*>(xt + (2 * (w_) + 1) * 272) = (xr[0].c_ >> 16) | (xr[1].c_ & 0xffff0000u);   \
  } while (0)
  SSD_XT(0, x); SSD_XT(1, y); SSD_XT(2, z); SSD_XT(3, w);
#undef SSD_XT
}

DI void ssd_states_phase(const Params& p, char* smem) {
  char* R = p.ws + O_R;
  const u16* xc = reinterpret_cast<const u16*>(R + R_XBCC);
  const float* dtb = reinterpret_cast<const float*>(R + R_DT);
  u16* stb = reinterpret_cast<u16*>(p.ws + O_HN);
  float* dec = reinterpret_cast<float*>(R + R_DEC);
  const int tid_ = opaque_tid();
  const int sub = tid_ >> 8;
  smem += sub * 53248;
  const int tid = tid_ & 255, lane = tid & 63, wave = tid >> 6, l31 = lane & 31, hh = lane >> 5;
  char* BTs = smem;
  char* xT = smem + 34816;
  float* csS = reinterpret_cast<float*>(smem + 52224);
  float* dtS = csS + 128;
#pragma unroll 1
  for (int base = blockIdx.x * 2; base < 4096; base += gridDim.x * 2) {
    const int item = base + sub, head = item & 15, grp = head >> 3;
    const size_t t0 = (size_t)(item >> 4) * 128;
    const u16* xcb = xc + (size_t)(unsigned)__builtin_amdgcn_readfirstlane((int)(t0 * 1536));
    const float Aneg = -__expf(reinterpret_cast<const float*>(p.in[20])[head]);
    if (wave == 0) ssd_scan_dt(dtb + (size_t)(unsigned)__builtin_amdgcn_readfirstlane((int)(t0 * 16)), head, Aneg, lane, csS, dtS);
    const int kc = tid & 15, rb = tid >> 4, kx = tid & 7, rx = tid >> 3;
    uint4 br0[4], br1[4], xr0[2], xr1[2];
#pragma unroll
    for (int i = 0; i < 4; ++i) {
      br0[i] = *reinterpret_cast<const uint4*>(xcb + (unsigned)((rb * 4 + i) * 1536 + 1024 + grp * 128 + kc * 8));
      br1[i] = *reinterpret_cast<const uint4*>(xcb + (unsigned)((64 + rb * 4 + i) * 1536 + 1024 + grp * 128 + kc * 8));
    }
#pragma unroll
    for (int i = 0; i < 2; ++i) {
      xr0[i] = *reinterpret_cast<const uint4*>(xcb + (unsigned)((rx * 2 + i) * 1536 + head * 64 + kx * 8));
      xr1[i] = *reinterpret_cast<const uint4*>(xcb + (unsigned)((64 + rx * 2 + i) * 1536 + head * 64 + kx * 8));
    }
    __syncthreads();
    const float cs_end = csS[127];
    ssd_stage_half(br0, xr0, 0, kc, rb, kx, rx, cs_end, csS, dtS, BTs, xT);
    ssd_stage_half(br1, xr1, 1, kc, rb, kx, rx, cs_end, csS, dtS, BTs, xT);
    __syncthreads();
    f32x16 hacc[2];
    {
      bf16x8 bfr[8], af0[8], af1[8];
      const char* bp = BTs + (32 * wave + l31) * 272 + hh * 16;
      const char* ap = xT + l31 * 272 + hh * 16;
#pragma unroll
      for (int ks = 0; ks < 8; ++ks) {
        bfr[ks] = *reinterpret_cast<const bf16x8*>(bp + ks * 32);
        af0[ks] = *reinterpret_cast<const bf16x8*>(ap + ks * 32);
        af1[ks] = *reinterpret_cast<const bf16x8*>(ap + 32 * 272 + ks * 32);
      }
      __builtin_amdgcn_sched_barrier(0);
#pragma unroll
      for (int pb = 0; pb < 2; ++pb)
#pragma unroll
        for (int i = 0; i < 16; ++i) hacc[pb][i] = 0.f;
#pragma unroll
      for (int ks = 0; ks < 8; ++ks) {
        hacc[0] = MFMA32(af0[ks], bfr[ks], hacc[0]);
        hacc[1] = MFMA32(af1[ks], bfr[ks], hacc[1]);
      }
      __builtin_amdgcn_sched_barrier(0);
    }
    u16* sp = stb + (size_t)item * 8192 + 32 * wave + l31;
#pragma unroll
    for (int pb = 0; pb < 2; ++pb)
#pragma unroll
      for (int i = 0; i < 16; ++i) sp[(pb * 32 + crow(i, hh)) * 128] = f2bf(hacc[pb][i]);
    if (tid == 0) dec[item] = ex2(cs_end * LOG2E_);
    __syncthreads();
  }
}

DI void ssd_scan_phase(const Params& p) {
  u32* stb = reinterpret_cast<u32*>(p.ws + O_HN);
  const float* dec = reinterpret_cast<const float*>(p.ws + O_R + R_DEC);
  const size_t gn = GN_;
  for (size_t u = GT_; u < (size_t)8 * 16 * 4096; u += gn) {
    const int bh = (int)(u >> 12), b = bh >> 4, h = bh & 15, pn2 = (int)u & 4095;
    u32* base = stb + ((size_t)(b * 32) * 16 + h) * 4096 + pn2;
    const float* dbase = dec + (size_t)(b * 32) * 16 + h;
    u32 v[32];
    float d[32];
#pragma unroll
    for (int c = 0; c < 32; ++c) { v[c] = base[(size_t)c * 16 * 4096]; d[c] = dbase[c * 16]; }
    asm volatile("" ::: "memory");
    float r0 = 0.f, r1 = 0.f;
#pragma unroll
    for (int c = 0; c < 32; ++c) {
      base[(size_t)c * 16 * 4096] = pack2(r0, r1);
      r0 = r0 * d[c] + bflo(v[c]);
      r1 = r1 * d[c] + bfhi(v[c]);
    }
  }
}

DI void ssd_out_phase(const Params& p, char* smem) {
  char* R = p.ws + O_R;
  const u16* xc = reinterpret_cast<const u16*>(R + R_XBCC);
  const float* dtb = reinterpret_cast<const float*>(R + R_DT);
  const u16* stb = reinterpret_cast<const u16*>(p.ws + O_HN);
  u16* yb = reinterpret_cast<u16*>(R + R_YCAT1);
  const int tid_ = opaque_tid();
  const int sub = tid_ >> 8;
  smem += sub * 45056;
  const int tid = tid_ & 255, lane = tid & 63, wave = tid >> 6, l31 = lane & 31, hh = lane >> 5;
  char* Bs = smem;
  char* xT = smem + 17408;
  char* Hs = smem + 26624;
  float* csS = reinterpret_cast<float*>(smem + 44032);
  float* dtS = csS + 128;
#pragma unroll 1
  for (int base = blockIdx.x * 2; base < 4096; base += gridDim.x * 2) {
    const int item = base + sub, head = item & 15, grp = head >> 3;
    const size_t t0 = (size_t)(item >> 4) * 128;
    const u16* xcb = xc + (size_t)(unsigned)__builtin_amdgcn_readfirstlane((int)(t0 * 1536));
    const float Aneg = -__expf(reinterpret_cast<const float*>(p.in[20])[head]);
    const float Dsk = reinterpret_cast<const float*>(p.in[21])[head];
    if (wave == 0) ssd_scan_dt(dtb + (size_t)(unsigned)__builtin_amdgcn_readfirstlane((int)(t0 * 16)), head, Aneg, lane, csS, dtS);
    const int lq = 32 * wave + l31;
    bf16x8 cf[8];
    {
      const u16* cp = xcb + (unsigned)(lq * 1536 + 1280 + grp * 128 + hh * 8);
#pragma unroll
      for (int ks = 0; ks < 8; ++ks) cf[ks] = *reinterpret_cast<const bf16x8*>(cp + ks * 16);
    }
    {
      const u16* hsrc = stb + (size_t)(unsigned)__builtin_amdgcn_readfirstlane(item * 8192);
#pragma unroll
      for (int i = 0; i < 4; ++i) {
        const int c = tid + 256 * i, row = c >> 4, kc = c & 15;
        *reinterpret_cast<uint4*>(Hs + row * 272 + kc * 16) = *reinterpret_cast<const uint4*>(hsrc + (unsigned)(row * 128 + kc * 8));
      }
    }
    __syncthreads();
    const float cs_l = csS[lq];
    f32x16 o[2];
    {
      bf16x8 h0[8], h1[8];
      const char* hp = Hs + l31 * 272 + hh * 16;
#pragma unroll
      for (int ks = 0; ks < 8; ++ks) {
        h0[ks] = *reinterpret_cast<const bf16x8*>(hp + ks * 32);
        h1[ks] = *reinterpret_cast<const bf16x8*>(hp + 32 * 272 + ks * 32);
      }
      __builtin_amdgcn_sched_barrier(0);
#pragma unroll
      for (int db = 0; db < 2; ++db)
#pragma unroll
        for (int i = 0; i < 16; ++i) o[db][i] = 0.f;
#pragma unroll
      for (int ks = 0; ks < 8; ++ks) {
        o[0] = MFMA32(h0[ks], cf[ks], o[0]);
        o[1] = MFMA32(h1[ks], cf[ks], o[1]);
      }
      __builtin_amdgcn_sched_barrier(0);
    }
    {
      const float el = ex2(cs_l * LOG2E_);
#pragma unroll
      for (int db = 0; db < 2; ++db)
#pragma unroll
        for (int i = 0; i < 16; ++i) o[db][i] *= el;
    }
#pragma unroll 1
    for (int j = 0; j < 2; ++j) {
      {
        const int kc = tid & 15, rb = tid >> 4;
        const u16* bsrc = xcb + (unsigned)((64 * j + rb * 4) * 1536 + 1024 + grp * 128 + kc * 8);
        const uint4 br0 = *reinterpret_cast<const uint4*>(bsrc);
        const uint4 br1 = *reinterpret_cast<const uint4*>(bsrc + 1536);
        const uint4 br2 = *reinterpret_cast<const uint4*>(bsrc + 2 * 1536);
        const uint4 br3 = *reinterpret_cast<const uint4*>(bsrc + 3 * 1536);
        const int kx = tid & 7, rx = tid >> 3;
        const u16* xsrc = xcb + (unsigned)((64 * j + rx * 2) * 1536 + head * 64 + kx * 8);
        const uint4 xr0 = *reinterpret_cast<const uint4*>(xsrc);
        const uint4 xr1 = *reinterpret_cast<const uint4*>(xsrc + 1536);
        if (j > 0) __syncthreads();
        char* bd = Bs + (rb * 4) * 272 + kc * 16;
        *reinterpret_cast<uint4*>(bd) = br0;
        *reinterpret_cast<uint4*>(bd + 272) = br1;
        *reinterpret_cast<uint4*>(bd + 2 * 272) = br2;
        *reinterpret_cast<uint4*>(bd + 3 * 272) = br3;
        char* xt = xT + (kx * 8) * 144 + rx * 4;
#define SSD_XT(w_, c_)                                                                                  \
  do {                                                                                                 \
    *reinterpret_cast<u32*>(xt + (2 * (w_)) * 144) = (xr0.c_ & 0xffffu) | (xr1.c_ << 16);               \
    *reinterpret_cast<u32*>(xt + (2 * (w_) + 1) * 144) = (xr0.c_ >> 16) | (xr1.c_ & 0xffff0000u);       \
  } while (0)
        SSD_XT(0, x); SSD_XT(1, y); SSD_XT(2, z); SSD_XT(3, w);
#undef SSD_XT
      }
      __syncthreads();
      if (64 * j <= 32 * wave + 31) {
        bf16x8 kf0[8], kf1[8];
        {
          const char* kp = Bs + l31 * 272 + hh * 16;
#pragma unroll
          for (int ks = 0; ks < 8; ++ks) {
            kf0[ks] = *reinterpret_cast<const bf16x8*>(kp + ks * 32);
            kf1[ks] = *reinterpret_cast<const bf16x8*>(kp + 32 * 272 + ks * 32);
          }
        }
        __builtin_amdgcn_sched_barrier(0);
        f32x16 st2[2];
#pragma unroll
        for (int kb = 0; kb < 2; ++kb)
#pragma unroll
          for (int i = 0; i < 16; ++i) st2[kb][i] = 0.f;
#pragma unroll
        for (int ks = 0; ks < 8; ++ks) {
          st2[0] = MFMA32(kf0[ks], cf[ks], st2[0]);
          st2[1] = MFMA32(kf1[ks], cf[ks], st2[1]);
        }
        __builtin_amdgcn_sched_barrier(0);
        uint4 vf[4][2];
#pragma unroll
        for (int s4 = 0; s4 < 4; ++s4)
#pragma unroll
          for (int db = 0; db < 2; ++db) {
            const char* vp = xT + (db * 32 + l31) * 144 + s4 * 32 + hh * 8;
            const uint2 lo = *reinterpret_cast<const uint2*>(vp);
            const uint2 hi = *reinterpret_cast<const uint2*>(vp + 16);
            vf[s4][db] = make_uint4(lo.x, lo.y, hi.x, hi.y);
          }
        __builtin_amdgcn_sched_barrier(0);
#pragma unroll
        for (int kb = 0; kb < 2; ++kb) {
#pragma unroll
          for (int g = 0; g < 4; ++g) {
            const int sb = 64 * j + kb * 32 + 8 * g + 4 * hh;
            const float4 c4 = *reinterpret_cast<const float4*>(csS + sb);
            const float4 d4 = *reinterpret_cast<const float4*>(dtS + sb);
            const float cv[4] = {c4.x, c4.y, c4.z, c4.w};
            const float dv[4] = {d4.x, d4.y, d4.z, d4.w};
#pragma unroll
            for (int e = 0; e < 4; ++e) {
              const int s = sb + e;
              const float v = st2[kb][4 * g + e] * ex2((cs_l - cv[e]) * LOG2E_) * dv[e];
              st2[kb][4 * g + e] = (s <= lq) ? v : 0.f;
            }
          }
#pragma unroll
          for (int s2 = 0; s2 < 2; ++s2) {
            const int s4 = kb * 2 + s2, bse = s2 * 8;
            uint4 pw;
            pw.x = pack2(st2[kb][bse + 0], st2[kb][bse + 1]);
            pw.y = pack2(st2[kb][bse + 2], st2[kb][bse + 3]);
            pw.z = pack2(st2[kb][bse + 4], st2[kb][bse + 5]);
            pw.w = pack2(st2[kb][bse + 6], st2[kb][bse + 7]);
            const bf16x8 pf = as_bf16x8(pw);
#pragma unroll
            for (int db = 0; db < 2; ++db) o[db] = MFMA32(as_bf16x8(vf[s4][db]), pf, o[db]);
          }
        }
      }
    }
    {
      u16* ybb = yb + (size_t)(unsigned)__builtin_amdgcn_readfirstlane((int)(t0 * 1536));
#pragma unroll
      for (int db = 0; db < 2; ++db)
#pragma unroll
        for (int g = 0; g < 4; ++g) {
          const int p0 = db * 32 + 8 * g + 4 * hh;
          const uint2 xv = *reinterpret_cast<const uint2*>(xcb + (unsigned)(lq * 1536 + head * 64 + p0));
          uint2 w;
          w.x = pack2(o[db][4 * g] + Dsk * bflo(xv.x), o[db][4 * g + 1] + Dsk * bfhi(xv.x));
          w.y = pack2(o[db][4 * g + 2] + Dsk * bflo(xv.y), o[db][4 * g + 3] + Dsk * bfhi(xv.y));
          *reinterpret_cast<uint2*>(ybb + (unsigned)(lq * 1536 + head * 64 + p0)) = w;
        }
    }
    __syncthreads();
  }
}

DI void merge_dsw_and_kpe(const Params& p, size_t gtid, size_t gthreads) {
  char* R = p.ws + O_R;
  const float* dsw = reinterpret_cast<const float*>(R + R_DSWO);
  const float* lse = reinterpret_cast<const float*>(R + R_LSE);
  u16* yc = reinterpret_cast<u16*>(p.ws + O_HN);
  const size_t n1 = (size_t)T_ * 64;
  for (size_t it = gtid; it < n1; it += gthreads) {
    const size_t tok = it >> 6;
    const int j = (int)(it >> 4) & 3, dq = (int)it & 15;
    const float l0 = lse[(0 * (size_t)T_ + tok) * 4 + j], l1 = lse[(1 * (size_t)T_ + tok) * 4 + j], l2 = lse[(2 * (size_t)T_ + tok) * 4 + j];
    const float mx = fmaxf(l0, fmaxf(l1, l2));
    const float e0 = __expf(l0 - mx), e1 = __expf(l1 - mx), e2 = __expf(l2 - mx);
    const float inv = 1.f / (e0 + e1 + e2);
    const float4 a = *reinterpret_cast<const float4*>(dsw + ((0 * (size_t)T_ + tok) * 4 + j) * 64 + dq * 4);
    const float4 b = *reinterpret_cast<const float4*>(dsw + ((1 * (size_t)T_ + tok) * 4 + j) * 64 + dq * 4);
    const float4 c = *reinterpret_cast<const float4*>(dsw + ((2 * (size_t)T_ + tok) * 4 + j) * 64 + dq * 4);
    const float w0 = e0 * inv, w1 = e1 * inv, w2 = e2 * inv;
    uint2 o;
    o.x = pack2(w0 * a.x + w1 * b.x + w2 * c.x, w0 * a.y + w1 * b.y + w2 * c.y);
    o.y = pack2(w0 * a.z + w1 * b.z + w2 * c.z, w0 * a.w + w1 * b.w + w2 * c.w);
    *reinterpret_cast<uint2*>(yc + tok * 1024 + j * 64 + dq * 4) = o;
  }
  const u16* cm = reinterpret_cast<const u16*>(R + R_CMLA);
  u16* kpe = reinterpret_cast<u16*>(R + R_KPE);
  const float2* rope = reinterpret_cast<const float2*>(p.ws + O_ROPE);
  const size_t n2 = (size_t)T_ * 16;
  for (size_t it = gtid; it < n2; it += gthreads) {
    const size_t tok = it >> 4;
    const int j = (int)it & 15;
    const float x1 = __uint_as_float((u32)cm[tok * 416 + 384 + j] << 16);
    const float x2 = __uint_as_float((u32)cm[tok * 416 + 384 + 16 + j] << 16);
    const float2 cs = rope[tok * 32 + 2 * j];
    kpe[tok * 32 + j] = f2bf(x1 * cs.x - x2 * cs.y);
    kpe[tok * 32 + 16 + j] = f2bf(x2 * cs.x + x1 * cs.y);
  }
}

DI void mla_row_scales(const Params& p) {
  char* R = p.ws + O_R;
  const u16* cm = reinterpret_cast<const u16*>(R + R_CMLA);
  float* rsq = reinterpret_cast<float*>(R + R_RSQ);
  float* rskv = reinterpret_cast<float*>(R + R_RSKV);
  const int ot = opaque_tid();
  const int lane = ot & 63;
  const int gw = blockIdx.x * (NTHR / 64) + (ot >> 6);
  const int nw = gridDim.x * (NTHR / 64);
  for (int t = gw; t < T_; t += nw) {
    const uint2 a = *reinterpret_cast<const uint2*>(cm + (size_t)t * 416 + lane * 4);
    const u32 b = *reinterpret_cast<const u32*>(cm + (size_t)t * 416 + 256 + lane * 2);
    float sq = bflo(a.x) * bflo(a.x) + bfhi(a.x) * bfhi(a.x) + bflo(a.y) * bflo(a.y) + bfhi(a.y) * bfhi(a.y);
    float sk = bflo(b) * bflo(b) + bfhi(b) * bfhi(b);
    sq = wave_sum(sq);
    sk = wave_sum(sk);
    if (lane == 0) {
      rsq[t] = rsqrtf(sq * (1.f / 256.f) + EPS_);
      rskv[t] = rsqrtf(sk * (1.f / 128.f) + EPS_);
    }
  }
}

DI void ffn_fixup(const Params& p, const float* __restrict__ cw, const float* __restrict__ cb, size_t gtid, size_t gthreads) {
  char* R = p.ws + O_R;
  const float* hg = reinterpret_cast<const float*>(R + R_HEADG);
  const float* hu = reinterpret_cast<const float*>(R + R_HEADU);
  const float* tg = reinterpret_cast<const float*>(R + R_TAILG);
  u16* act = reinterpret_cast<u16*>(R + R_GU);
  for (size_t it = gtid; it < 128ull * 2816; it += gthreads) {
    const int mt = (int)(it / 2816), ch = (int)(it % 2816);
    float t2 = 0.f, t1 = 0.f;
    if ((mt & 15) != 0) { t2 = tg[((size_t)(mt - 1) * 2) * 2816 + ch]; t1 = tg[((size_t)(mt - 1) * 2 + 1) * 2816 + ch]; }
    const float g0 = hg[((size_t)mt * 2) * 2816 + ch], g1 = hg[((size_t)mt * 2 + 1) * 2816 + ch];
    const float u0 = hu[((size_t)mt * 2) * 2816 + ch], u1 = hu[((size_t)mt * 2 + 1) * 2816 + ch];
    const float b = cb[ch], w0 = cw[ch], w1 = cw[2816 + ch], w2 = cw[2 * 2816 + ch];
    act[((size_t)mt * 256) * 2816 + ch] = f2bf(siluf(b + w0 * t2 + w1 * t1 + w2 * g0) * u0);
    act[((size_t)mt * 256 + 1) * 2816 + ch] = f2bf(siluf(b + w0 * t1 + w1 * g0 + w2 * g1) * u1);
  }
}

DI void ssm_fixup(const Params& p, size_t gtid, size_t gthreads) {
  char* R = p.ws + O_R;
  const float* hx = reinterpret_cast<const float*>(R + R_HEADX);
  const float* tx = reinterpret_cast<const float*>(R + R_TAILX);
  u16* xo = reinterpret_cast<u16*>(R + R_XBCC);
  const float* cw = reinterpret_cast<const float*>(p.in[17]);
  const float* cb = reinterpret_cast<const float*>(p.in[18]);
  for (size_t it = gtid; it < 128ull * 1536; it += gthreads) {
    const int mt = (int)(it / 1536), ch = (int)(it % 1536);
    float t3 = 0.f, t2 = 0.f, t1 = 0.f;
    if ((mt & 15) != 0) {
      const float* t = tx + ((size_t)(mt - 1) * 3) * 1536 + ch;
      t3 = t[0]; t2 = t[1536]; t1 = t[2 * 1536];
    }
    const float* h = hx + ((size_t)mt * 3) * 1536 + ch;
    const float g0 = h[0], g1 = h[1536], g2 = h[2 * 1536];
    const float b = cb[ch], w0 = cw[ch], w1 = cw[1536 + ch], w2 = cw[2 * 1536 + ch], w3 = cw[3 * 1536 + ch];
    u16* o = xo + ((size_t)mt * 256) * 1536 + ch;
    o[0] = f2bf(siluf(b + w0 * t3 + w1 * t2 + w2 * t1 + w3 * g0));
    o[1536] = f2bf(siluf(b + w0 * t2 + w1 * t1 + w2 * g0 + w3 * g1));
    o[2 * 1536] = f2bf(siluf(b + w0 * t1 + w1 * g0 + w2 * g1 + w3 * g2));
  }
}

DI void ssm_gate_norm(const Params& p) {
  char* R = p.ws + O_R;
  u16* yb = reinterpret_cast<u16*>(R + R_YCAT1);
  const u16* zb = reinterpret_cast<const u16*>(R + R_Z);
  const float* gn = reinterpret_cast<const float*>(p.in[22]);
  const int ot = opaque_tid();
  const int lane = ot & 63;
  const int gw = blockIdx.x * (NTHR / 64) + (ot >> 6);
  const int nw = gridDim.x * (NTHR / 64);
  constexpr int U = 4;
  for (int it0 = gw; it0 < T_ * 2; it0 += nw * U) {
    uint4 yv[U], zv[U];
#pragma unroll
    for (int u = 0; u < U; ++u) {
      const int it = (it0 + u * nw < T_ * 2) ? it0 + u * nw : it0;
      const size_t t = it >> 1;
      const int g = it & 1;
      yv[u] = *reinterpret_cast<const uint4*>(yb + t * 1536 + g * 512 + lane * 8);
      zv[u] = *reinterpret_cast<const uint4*>(zb + t * 1024 + g * 512 + lane * 8);
    }
    asm volatile("" ::: "memory");
#pragma unroll
    for (int u = 0; u < U; ++u) {
      const int it = it0 + u * nw;
      const size_t t = it >> 1;
      const int g = it & 1;
      float y[8], z[8];
      unpack8(yv[u], y);
      unpack8(zv[u], z);
      float ss = 0.f;
#pragma unroll
      for (int e = 0; e < 8; ++e) { y[e] *= siluf(z[e]); ss += y[e] * y[e]; }
      ss = wave_sum(ss);
      const float sc = rsqrtf(ss * (1.f / 512.f) + EPS_);
      const float* gp = gn + g * 512 + lane * 8;
      uint4 o;
      o.x = pack2(y[0] * sc * gp[0], y[1] * sc * gp[1]); o.y = pack2(y[2] * sc * gp[2], y[3] * sc * gp[3]);
      o.z = pack2(y[4] * sc * gp[4], y[5] * sc * gp[5]); o.w = pack2(y[6] * sc * gp[6], y[7] * sc * gp[7]);
      if (it < T_ * 2) *reinterpret_cast<uint4*>(yb + t * 1536 + g * 512 + lane * 8) = o;
    }
  }
}

DI void grid_barrier(unsigned* ctr, unsigned& epoch) {
  asm volatile("s_waitcnt vmcnt(0)" ::: "memory");
  __syncthreads();
  epoch += 1;
  if (threadIdx.x == 0) {
    __builtin_amdgcn_fence(__ATOMIC_RELEASE, "agent");
    asm volatile("s_waitcnt vmcnt(0)" ::: "memory");
    __hip_atomic_fetch_add(ctr, 1u, __ATOMIC_RELAXED, __HIP_MEMORY_SCOPE_AGENT);
    const unsigned target = epoch * gridDim.x;
    while (__hip_atomic_load(ctr, __ATOMIC_RELAXED, __HIP_MEMORY_SCOPE_AGENT) < target) __builtin_amdgcn_s_sleep(1);
    __builtin_amdgcn_fence(__ATOMIC_ACQUIRE, "agent");
    asm volatile("s_waitcnt vmcnt(0)" ::: "memory");
  }
  __syncthreads();
}

__global__ void __launch_bounds__(NTHR, 2) fwd_megakernel(Params p) {
  extern __shared__ __attribute__((aligned(16))) char smem[];
  cg::grid_group grid = cg::this_grid();
  unsigned* bar = reinterpret_cast<unsigned*>(p.ws + WS_BAR);
  unsigned epoch = 0;
  float* ssq = reinterpret_cast<float*>(p.ws + WS_SS);
  u16* xb1 = reinterpret_cast<u16*>(p.out);
  char* ws = p.ws;
  char* R = ws + O_R;
  auto F = [&](int i) { return reinterpret_cast<const float*>(p.in[i]); };
  auto W16 = [&](size_t off) { return reinterpret_cast<u16*>(ws + off); };
  u16* hn = W16(O_HN);

#pragma unroll 1
  for (int job = 0; job < 12; ++job) {
    const float* W; u16* Wt; int K, N, Npad, cmode = 0; const float* gain = nullptr;
    switch (job) {
      case 0: W = F(3); Wt = W16(O_WIN0); K = 1024; N = 2720; Npad = 2816; cmode = 1; break;
      case 1: W = F(5); Wt = W16(O_WUQ); K = 256; N = 1152; Npad = 1280; cmode = 2; gain = F(4); break;
      case 2: W = F(7); Wt = W16(O_WUKV); K = 128; N = 1536; Npad = 1536; gain = F(6); break;
      case 3: W = F(8); Wt = W16(O_WOUT0); K = 1024; N = 1024; Npad = 1024; break;
      case 4: cvt_weight_gu(F(10), F(11), W16(O_WGU0), F(9), GT_, GN_); continue;
      case 5: cvt_weight_gu(F(25), F(26), W16(O_WGU1), F(24), GT_, GN_); continue;
      case 6: W = F(14); Wt = W16(O_WDN0); K = 2816; N = 1024; Npad = 1024; break;
      case 7: W = F(16); Wt = W16(O_WIN1); K = 1024; N = 4112; Npad = 4352; gain = F(15); break;
      case 8: W = F(23); Wt = W16(O_WOUT1); K = 1536; N = 1024; Npad = 1024; break;
      case 9: continue;
      case 10: continue;
      default: W = F(29); Wt = W16(O_WDN1); K = 2816; N = 1024; Npad = 1024; break;
    }
    cvt_weight(W, Wt, K, N, Npad, cmode, gain, GT_, GN_);
  }
  {
    float2* rope = reinterpret_cast<float2*>(ws + O_ROPE);
    const int* pos = reinterpret_cast<const int*>(p.in[1]);
    const size_t gn = GN_;
    for (size_t it = GT_; it < (size_t)T_ * 32; it += gn) {
      const int i = (int)it & 31;
      const float inv = 1.0f / powf(10000.f, (float)i * (2.0f / 64.f));
      const float ang = (float)pos[it >> 5] * inv;
      float sn, cs;
      sincosf(ang, &sn, &cs);
      rope[it] = make_float2(cs, sn);
    }
  }
  rmsnorm_rows<false>(F(0), F(2), hn);
  grid.sync();

  { GemmDesc d{hn, 1024, W16(O_WIN0), 1024, 11, nullptr, nullptr, nullptr, nullptr, nullptr}; gemm_phase<EPI_IN0>(p, d, smem); }
  grid_barrier(bar, epoch);
  mla_row_scales(p);
  attn_phase<1>(p, smem);
  grid_barrier(bar, epoch);
  merge_dsw_and_kpe(p, GT_, GN_);
  {
    const u16* cm = reinterpret_cast<const u16*>(R + R_CMLA);
    GemmDesc dq{cm, 416, W16(O_WUQ), 256, 5, nullptr, nullptr, nullptr, nullptr, nullptr};
    gemm_phase<EPI_UQ>(p, dq, smem);
    GemmDesc dk{cm + 256, 416, W16(O_WUKV), 128, 6, nullptr, nullptr, nullptr, nullptr, nullptr};
    gemm_phase<EPI_UKV>(p, dk, smem);
  }
  grid_barrier(bar, epoch);
  attn_phase<0>(p, smem);
  grid_barrier(bar, epoch);
  { GemmDesc d{hn, 1024, W16(O_WOUT0), 1024, 4, F(0), nullptr, nullptr, reinterpret_cast<u16*>(R + R_XB0), ssq}; gemm_phase<EPI_RES>(p, d, smem); }
  grid_barrier(bar, epoch);
  { GemmDesc d{reinterpret_cast<const u16*>(R + R_XB0), 1024, W16(O_WGU0), 1024, 22, F(12), const_cast<float*>(F(13)), nullptr, nullptr, ssq}; gemm_phase<EPI_GU>(p, d, smem); }
  grid_barrier(bar, epoch);
  ffn_fixup(p, F(12), F(13), GT_, GN_);
  grid_barrier(bar, epoch);
  {
    const u16* act = reinterpret_cast<const u16*>(R + R_GU);
    GemmDesc d{act, 2816, W16(O_WDN0), 2816, 4, nullptr, nullptr, reinterpret_cast<const u16*>(R + R_XB0), xb1, ssq + 4 * T_};
    gemm_phase<EPI_RES>(p, d, smem);
  }
  grid_barrier(bar, epoch);
  { GemmDesc d{xb1, 1024, W16(O_WIN1), 1024, 17, nullptr, nullptr, nullptr, nullptr, ssq + 4 * T_}; gemm_phase<EPI_IN1>(p, d, smem); }
  grid_barrier(bar, epoch);
  ssm_fixup(p, GT_, GN_);
  grid_barrier(bar, epoch);
  ssd_states_phase(p, smem);
  attn_phase<2>(p, smem);
  grid_barrier(bar, epoch);
  ssd_scan_phase(p);
  grid_barrier(bar, epoch);
  ssd_out_phase(p, smem);
  grid_barrier(bar, epoch);
  ssm_gate_norm(p);
  grid_barrier(bar, epoch);
  {
    const u16* yc1 = reinterpret_cast<const u16*>(R + R_YCAT1);
    GemmDesc d{yc1, 1536, W16(O_WOUT1), 1536, 4, nullptr, nullptr, xb1, hn, ssq + 8 * T_};
    gemm_phase<EPI_RES>(p, d, smem);
  }
  grid_barrier(bar, epoch);
  { GemmDesc d{hn, 1024, W16(O_WGU1), 1024, 22, F(27), const_cast<float*>(F(28)), nullptr, nullptr, ssq + 8 * T_}; gemm_phase<EPI_GU>(p, d, smem); }
  grid_barrier(bar, epoch);
  ffn_fixup(p, F(27), F(28), GT_, GN_);
  grid_barrier(bar, epoch);
  {
    const u16* act = reinterpret_cast<const u16*>(R + R_GU);
    GemmDesc d{act, 2816, W16(O_WDN1), 2816, 4, nullptr, p.out, hn, nullptr, nullptr};
    gemm_phase<EPI_RES>(p, d, smem);
  }
  grid_barrier(bar, epoch);
  rmsnorm_rows<true>(p.out, F(30), p.out);
}

extern "C" void kernel_launch(void* const* d_in, const int* in_sizes, int n_in, void* d_out, int out_size,
                              void* d_ws, size_t ws_size, hipStream_t stream) {
  static int grid_blocks = 0;
  if (!grid_blocks) {
    int dev = 0, cus = 0, per_cu = 0;
    hipGetDevice(&dev);
    hipDeviceGetAttribute(&cus, hipDeviceAttributeMultiprocessorCount, dev);
    hipFuncSetAttribute(reinterpret_cast<const void*>(fwd_megakernel), hipFuncAttributeMaxDynamicSharedMemorySize, SMEM_BYTES);
    hipOccupancyMaxActiveBlocksPerMultiprocessor(&per_cu, fwd_megakernel, NTHR, SMEM_BYTES);
    if (per_cu > 1) per_cu = 1;
    if (per_cu < 1) per_cu = 1;
    grid_blocks = cus * per_cu;
  }
  if (ws_size < WS_NEED) fprintf(stderr, "workspace too small: %zu < %zu\n", ws_size, (size_t)WS_NEED);
  Params p{};
  for (int i = 0; i < 31; ++i) p.in[i] = d_in[i];
  p.out = reinterpret_cast<float*>(d_out);
  p.ws = reinterpret_cast<char*>(d_ws);
  hipMemsetAsync(reinterpret_cast<char*>(d_ws) + WS_BAR, 0, 256, stream);
  void* args[] = {&p};
  hipError_t e = hipLaunchCooperativeKernel(reinterpret_cast<void*>(fwd_megakernel), dim3(grid_blocks), dim3(NTHR), args, SMEM_BYTES, stream);
  if (e != hipSuccess) fprintf(stderr, "cooperative launch failed: %s (grid %d)\n", hipGetErrorString(e), grid_blocks);
}
```

```cpp
#include <hip/hip_runtime.h>
#include <hip/hip_bf16.h>
#include <hip/hip_cooperative_groups.h>
#include <cstdio>
namespace cg = cooperative_groups;

typedef unsigned short u16;
typedef unsigned int u32;
using bf16x8 = __attribute__((ext_vector_type(8))) short;
using f32x16 = __attribute__((ext_vector_type(16))) float;
#define MFMA32(a, b, c) __builtin_amdgcn_mfma_f32_32x32x16_bf16((a), (b), (c), 0, 0, 0)
#define DI __device__ __forceinline__

constexpr int T_ = 32768;
constexpr int SEQ_ = 4096;
constexpr float EPS_ = 1e-6f;
constexpr float LOG2E_ = 1.4426950408889634f;
constexpr float LN2_ = 0.6931471805599453f;

constexpr size_t SZ_WIN0 = 2816ull * 1024 * 2;
constexpr size_t SZ_WUQ = 1280ull * 256 * 2;
constexpr size_t SZ_WUKV = 1536ull * 128 * 2;
constexpr size_t SZ_WOUT0 = 1024ull * 1024 * 2;
constexpr size_t SZ_WGU = 5632ull * 1024 * 2;
constexpr size_t SZ_WDN = 1024ull * 2816 * 2;
constexpr size_t SZ_WIN1 = 4352ull * 1024 * 2;
constexpr size_t SZ_WOUT1 = 1024ull * 1536 * 2;
constexpr size_t O_WIN0 = 0;
constexpr size_t O_WUQ = O_WIN0 + SZ_WIN0;
constexpr size_t O_WUKV = O_WUQ + SZ_WUQ;
constexpr size_t O_WOUT0 = O_WUKV + SZ_WUKV;
constexpr size_t O_WGU0 = O_WOUT0 + SZ_WOUT0;
constexpr size_t O_WDN0 = O_WGU0 + SZ_WGU;
constexpr size_t O_WIN1 = O_WDN0 + SZ_WDN;
constexpr size_t O_WOUT1 = O_WIN1 + SZ_WIN1;
constexpr size_t O_WGU1 = O_WOUT1 + SZ_WOUT1;
constexpr size_t O_WDN1 = O_WGU1 + SZ_WGU;
constexpr size_t O_ROPE = O_WDN1 + SZ_WDN;
constexpr size_t O_HN = O_ROPE + (size_t)T_ * 32 * 8;
constexpr size_t O_R = O_HN + (size_t)T_ * 1024 * 2;
constexpr size_t R_QKV0 = 0;
constexpr size_t R_QMLA = 0;
constexpr size_t R_KMLA = R_QMLA + (size_t)T_ * 1152 * 2;
constexpr size_t R_CMLA = R_QKV0 + (size_t)T_ * 2304 * 2;
constexpr size_t R_DSWO = R_CMLA + (size_t)T_ * 416 * 2;
constexpr size_t R_LSE = R_DSWO + 3ull * T_ * 256 * 4;
constexpr size_t R_KPE = R_LSE + 3ull * T_ * 4 * 4;
constexpr size_t R_VMLA = R_KPE + (size_t)T_ * 32 * 2;
constexpr size_t R_RSQ = R_VMLA + (size_t)T_ * 768 * 2;
constexpr size_t R_RSKV = R_RSQ + (size_t)T_ * 4;
constexpr size_t R_END0 = R_RSKV + (size_t)T_ * 4;
constexpr size_t R_GU = 0;
constexpr size_t R_XB0 = 200ull << 20;
constexpr size_t R_HEADG = (size_t)T_ * 2816 * 2;
constexpr size_t R_HEADU = R_HEADG + 128ull * 2 * 2816 * 4;
constexpr size_t R_TAILG = R_HEADU + 128ull * 2 * 2816 * 4;
constexpr size_t R_ENDF = R_TAILG + 128ull * 2 * 2816 * 4;
constexpr size_t R_Z = 0;
constexpr size_t R_XBCR = R_Z + (size_t)T_ * 1024 * 2;
constexpr size_t R_YCAT1 = R_XBCR;
constexpr size_t R_QKV1 = R_XBCR + (size_t)T_ * 1536 * 2;
constexpr size_t R_XBCC = R_QKV1 + (size_t)T_ * 1536 * 2;
constexpr size_t R_DT = R_XBCC + (size_t)T_ * 1536 * 2;
constexpr size_t R_DEC = R_DT + (size_t)T_ * 16 * 4;
constexpr size_t R_HEADX = R_DEC + 4096 * 4;
constexpr size_t R_TAILX = R_HEADX + 128ull * 3 * 1536 * 4;
constexpr size_t R_END1 = R_TAILX + 128ull * 3 * 1536 * 4;
constexpr size_t R_SIZE = (R_END1 > R_ENDF ? (R_END1 > R_END0 ? R_END1 : R_END0) : (R_ENDF > R_END0 ? R_ENDF : R_END0));
constexpr size_t WS_BAR = O_R + R_SIZE;
constexpr size_t WS_SS = WS_BAR + 256;
constexpr size_t WS_NEED = WS_SS + 3ull * T_ * 16;
static_assert(R_KMLA + (size_t)T_ * 768 * 2 <= R_CMLA, "mla alias overflow");
static_assert(WS_NEED <= 536870912ull, "workspace too large");
static_assert(R_XB0 >= R_DSWO && R_XB0 + (size_t)T_ * 1024 * 2 <= R_LSE, "xb0 must sit inside the (dead) dsw output buffer");

constexpr int SMEM_BYTES = 131072 + 4096;
constexpr int NTHR = 512;

struct Params {
  const void* in[31];
  float* out;
  char* ws;
};

typedef __attribute__((ext_vector_type(2))) __bf16 bf16x2_t;
typedef __attribute__((ext_vector_type(2))) float f32x2_t;
DI u32 pack2(float a, float b) {
  const f32x2_t v = {a, b};
  return __builtin_bit_cast(u32, __builtin_convertvector(v, bf16x2_t));
}
DI u32 pack2_old(float a, float b) {
  __hip_bfloat162 y = __float22bfloat162_rn(make_float2(a, b));
  return *reinterpret_cast<u32*>(&y);
}
DI u16 f2bf(float a) {
  __hip_bfloat16 y = __float2bfloat16(a);
  return *reinterpret_cast<u16*>(&y);
}
DI float bflo(u32 w) { return __uint_as_float(w << 16); }
DI float bfhi(u32 w) { return __uint_as_float(w & 0xffff0000u); }
DI float ex2(float x) { return __builtin_amdgcn_exp2f(x); }
DI float lg2(float x) { return __builtin_amdgcn_logf(x); }
DI float siluf(float v) { return v * __builtin_amdgcn_rcpf(1.f + ex2(-v * LOG2E_)); }
DI int crow(int i, int h) { return (i & 3) + 8 * (i >> 2) + 4 * h; }
DI bf16x8 as_bf16x8(uint4 v) { return __builtin_bit_cast(bf16x8, v); }
DI void unpack8(uint4 v, float* f) {
  f[0] = bflo(v.x); f[1] = bfhi(v.x); f[2] = bflo(v.y); f[3] = bfhi(v.y);
  f[4] = bflo(v.z); f[5] = bfhi(v.z); f[6] = bflo(v.w); f[7] = bfhi(v.w);
}
DI int opaque_tid() { int t = threadIdx.x; asm volatile("" : "+v"(t)); return t; }
#define GT_ ((size_t)blockIdx.x * NTHR + opaque_tid())
#define GN_ ((size_t)gridDim.x * NTHR)
DI float wave_sum(float v) {
#pragma unroll
  for (int o = 32; o >= 1; o >>= 1) v += __shfl_xor(v, o);
  return v;
}

DI int colmap(int n, int cmode) {
  const int cb = n & ~31, u = n & 31, nb = u >> 4, fr = u & 15;
  if (cmode == 1 && n < 1536) return (n & ~63) + ((n >> 5) & 1) * 16 + fr + 32 * nb;
  if (cmode == 2 && ((cb % 96) >> 5) == 2) return n;
  return cb + 2 * fr + nb;
}
DI void cvt_weight(const float* __restrict__ W, u16* __restrict__ Wt, int K, int N, int Npad, int cmode,
                   const float* __restrict__ gain, size_t gtid, size_t gthreads) {
  const size_t items = (size_t)Npad * (K >> 3);
  for (size_t it = gtid; it < items; it += gthreads) {
    const int n = (int)(it % Npad);
    const int kc = (int)(it / Npad);
    const int lc = colmap(n, cmode);
    float v[8];
#pragma unroll
    for (int j = 0; j < 8; ++j) {
      const int k = kc * 8 + j;
      float w = (lc < N) ? W[(size_t)k * N + lc] : 0.f;
      if (gain) w *= gain[k];
      v[j] = w;
    }
    uint4 o;
    o.x = pack2(v[0], v[1]); o.y = pack2(v[2], v[3]); o.z = pack2(v[4], v[5]); o.w = pack2(v[6], v[7]);
    *reinterpret_cast<uint4*>(Wt + (size_t)n * K + kc * 8) = o;
  }
}

DI void cvt_weight_gu(const float* __restrict__ Wg, const float* __restrict__ Wu, u16* __restrict__ Wt, const float* __restrict__ gain,
                      size_t gtid, size_t gthreads) {
  const size_t items = 5632ull * 128;
  for (size_t it = gtid; it < items; it += gthreads) {
    const int n = (int)(it % 5632);
    const int kc = (int)(it / 5632);
    const int pn = n >> 8, bj = (n >> 7) & 1, wc = (n >> 5) & 3, nb = (n >> 4) & 1, fr = n & 15;
    const int ch = pn * 128 + (wc * 16 + fr) * 2 + bj;
    const float* W = nb ? Wu : Wg;
    float v[8];
#pragma unroll
    for (int j = 0; j < 8; ++j) v[j] = W[(size_t)(kc * 8 + j) * 2816 + ch] * gain[kc * 8 + j];
    uint4 o;
    o.x = pack2(v[0], v[1]); o.y = pack2(v[2], v[3]); o.z = pack2(v[4], v[5]); o.w = pack2(v[6], v[7]);
    *reinterpret_cast<uint4*>(Wt + (size_t)n * 1024 + kc * 8) = o;
  }
}

template <bool OUTF32>
DI void rmsnorm_rows(const float* src, const float* __restrict__ g, void* dst) {
  const int ot = opaque_tid();
  const int lane = ot & 63;
  const int gw = blockIdx.x * (NTHR / 64) + (ot >> 6);
  const int nw = gridDim.x * (NTHR / 64);
  constexpr int U = 4;
  float4 g4[4];
#pragma unroll
  for (int i = 0; i < 4; ++i) g4[i] = reinterpret_cast<const float4*>(g)[lane + 64 * i];
  for (int row0 = gw; row0 < T_; row0 += nw * U) {
    float4 v[U][4];
#pragma unroll
    for (int u = 0; u < U; ++u) {
      const int row = row0 + u * nw;
      const float4* s = reinterpret_cast<const float4*>(src + (size_t)(row < T_ ? row : row0) * 1024);
#pragma unroll
      for (int i = 0; i < 4; ++i) v[u][i] = s[lane + 64 * i];
    }
    asm volatile("" ::: "memory");
#pragma unroll
    for (int u = 0; u < U; ++u) {
      const int row = row0 + u * nw;
      float ss = 0.f;
#pragma unroll
      for (int i = 0; i < 4; ++i) ss += v[u][i].x * v[u][i].x + v[u][i].y * v[u][i].y + v[u][i].z * v[u][i].z + v[u][i].w * v[u][i].w;
      ss = wave_sum(ss);
      const float sc = rsqrtf(ss * (1.f / 1024.f) + EPS_);
      if (row < T_) {
#pragma unroll
        for (int i = 0; i < 4; ++i) {
          const float a = v[u][i].x * sc * g4[i].x, b = v[u][i].y * sc * g4[i].y, c = v[u][i].z * sc * g4[i].z, d = v[u][i].w * sc * g4[i].w;
          if (OUTF32) {
            reinterpret_cast<float4*>(reinterpret_cast<float*>(dst) + (size_t)row * 1024)[lane + 64 * i] = make_float4(a, b, c, d);
          } else {
            uint2 o;
            o.x = pack2(a, b); o.y = pack2(c, d);
            reinterpret_cast<uint2*>(reinterpret_cast<u16*>(dst) + (size_t)row * 1024)[lane + 64 * i] = o;
          }
        }
      }
    }
  }
}

enum { EPI_IN0 = 0, EPI_UQ, EPI_UKV, EPI_RES, EPI_GU, EPI_IN1 };
using f32x4 = __attribute__((ext_vector_type(4))) float;

struct GemmDesc {
  const u16* A; int lda;
  const u16* Bt; int K; int nN;
  const float* res; float* dst;
  const u16* res16;
  u16* xb; float* ss;
};

DI const char* uniform_ptr(const void* q) {
  const unsigned long long v = (unsigned long long)q;
  const unsigned lo = __builtin_amdgcn_readfirstlane((unsigned)v), hi = __builtin_amdgcn_readfirstlane((unsigned)(v >> 32));
  return reinterpret_cast<const char*>(((unsigned long long)hi << 32) | lo);
}
DI int lds_byte(int r, int c) {
  const int st = (r >> 4) * 2 + (c >> 5), rr = r & 15, cc = c & 31, ob = rr * 64 + cc * 2;
  return st * 1024 + (ob ^ (((ob >> 9) & 1) << 5));
}
DI void stage_rc(int b, int& Rr, int& Cc) {
  const int st = b / 1024, sb = b % 1024, swz = sb ^ (((sb >> 9) & 1) << 5);
  Rr = (st >> 1) * 16 + swz / 64;
  Cc = (st & 1) * 32 + (swz % 64) / 2;
}

template <int EPI>
DI void gemm_store(const Params& p, const GemmDesc& d, int row, int cb, int fr, float v0, float v1, float2 cs, float s) {
  char* R = p.ws + O_R;
  if (EPI == EPI_IN0) {
    u16* qkv = reinterpret_cast<u16*>(R + R_QKV0);
    if (cb < 1536) {
      const int dd = ((cb >> 5) & 1) * 16 + fr;
      u16* o = qkv + (size_t)row * 2304 + (cb & ~63) + dd;
      o[0] = f2bf(v0 * cs.x - v1 * cs.y);
      o[32] = f2bf(v1 * cs.x + v0 * cs.y);
    } else {
      const int c0 = cb + 2 * fr;
      if (c0 < 2304) *reinterpret_cast<u32*>(qkv + (size_t)row * 2304 + c0) = pack2_old(v0, v1);
      else if (c0 < 2720) *reinterpret_cast<u32*>(reinterpret_cast<u16*>(R + R_CMLA) + (size_t)row * 416 + (c0 - 2304)) = pack2_old(v0, v1);
    }
  } else if (EPI == EPI_UQ) {
    if (cb < 1152) {
      u16* qm = reinterpret_cast<u16*>(R + R_QMLA);
      v0 *= s; v1 *= s;
      if (((cb % 96) >> 5) == 2) {
        qm[(size_t)row * 1152 + cb + fr] = f2bf(v0 * cs.x - v1 * cs.y);
        qm[(size_t)row * 1152 + cb + 16 + fr] = f2bf(v1 * cs.x + v0 * cs.y);
      } else {
        *reinterpret_cast<u32*>(qm + (size_t)row * 1152 + cb + 2 * fr) = pack2_old(v0, v1);
      }
    }
  } else if (EPI == EPI_UKV) {
    const int c0 = cb + 2 * fr, head = c0 >> 7, w = c0 & 127;
    u16* dp = (w < 64) ? (reinterpret_cast<u16*>(R + R_KMLA) + head * 64 + w) : (reinterpret_cast<u16*>(R + R_VMLA) + head * 64 + (w - 64));
    *reinterpret_cast<u32*>(dp + (size_t)row * 768) = pack2_old(v0 * s, v1 * s);
  }
}

DI void gemm_tile_coords(int L, int nwg, int nN, int& brow, int& bcol) {
  int wgid = L;
  const int q = nwg / 8, r = nwg % 8, xcd = wgid % 8, off = wgid / 8;
  wgid = (xcd < r ? xcd * (q + 1) : r * (q + 1) + (xcd - r) * q) + off;
  const int nig = 8 * nN, gid = wgid / nig, fm = gid * 8;
  const int pm = fm + ((wgid % nig) % 8), pn = (wgid % nig) / 8;
  brow = pm * 256; bcol = pn * 256;
}

template <int EPI>
DI void gemm_phase(const Params& p, const GemmDesc d, char* smem) {
  constexpr int BK = 64, HALF = 128, HT = HALF * BK;
  u16* shm = reinterpret_cast<u16*>(smem);
  const float* rs = reinterpret_cast<const float*>(p.ws + O_R + (EPI == EPI_UQ ? R_RSQ : R_RSKV));
  int tid_ = threadIdx.x;
  asm volatile("" : "+v"(tid_));
  const int tid = tid_;
  const int wid = tid >> 6, lane = tid & 63, wr = wid >> 2, wc = wid & 3, fr = lane & 15, fq = lane >> 4;
  const int K = d.K, lda = d.lda, nt = K / BK;
  const u16* A = d.A;
  const u16* Bt = d.Bt;
  const int nM = 128, nN = d.nN, nwg = nM * nN;
  constexpr int AH = (EPI == EPI_GU || EPI == EPI_IN1) ? 16 : 128;
  const int wbase = __builtin_amdgcn_readfirstlane(tid >> 6) * 1024;
  unsigned voA0, voA1, voB0, voB1;
  {
    int r0, c0, r1, c1;
    stage_rc(tid * 16, r0, c0);
    stage_rc(tid * 16 + 8192, r1, c1);
    const int pr0 = (EPI == EPI_GU || EPI == EPI_IN1) ? (((r0 >> 6) * 4 + ((r0 >> 2) & 3)) * 32 + ((r0 >> 4) & 3) * 4 + (r0 & 3)) : r0;
    const int pr1 = (EPI == EPI_GU || EPI == EPI_IN1) ? (((r1 >> 6) * 4 + ((r1 >> 2) & 3)) * 32 + ((r1 >> 4) & 3) * 4 + (r1 & 3)) : r1;
    voA0 = (unsigned)(pr0 * lda + c0) * 2u; voA1 = (unsigned)(pr1 * lda + c1) * 2u;
    voB0 = (unsigned)(r0 * K + c0) * 2u; voB1 = (unsigned)(r1 * K + c1) * 2u;
  }
#define SA(b, h) (shm + ((b) * 2 + (h)) * HT)
#define SB(b, h) (shm + (4 + (b) * 2 + (h)) * HT)
#define STAGE(P, BASE, LD, br, kt, VO0, VO1)                                                         \
  do {                                                                                               \
    const char* _sb = uniform_ptr((BASE) + (long)(br) * (LD) + (long)(kt) * BK);                     \
    __builtin_amdgcn_global_load_lds((const unsigned*)(_sb + (VO0)), (unsigned*)((char*)(P) + wbase), 16, 0, 0);        \
    __builtin_amdgcn_global_load_lds((const unsigned*)(_sb + (VO1)), (unsigned*)((char*)(P) + wbase + 8192), 16, 0, 0); \
  } while (0)
#define STA(P, br, kt) STAGE(P, A, lda, br, kt, voA0, voA1)
#define STB(P, br, kt) STAGE(P, Bt, K, br, kt, voB0, voB1)
#define LDA(dst, b, h)                                                                               \
  for (int m = 0; m < 4; ++m)                                                                        \
    for (int k = 0; k < 2; ++k)                                                                      \
      dst[m][k] = *reinterpret_cast<const bf16x8*>((char*)SA(b, h) + lds_byte(wr * 64 + m * 16 + fr, k * 32 + fq * 8))
#define LDB(dst, b, h)                                                                               \
  for (int n = 0; n < 2; ++n)                                                                        \
    for (int k = 0; k < 2; ++k)                                                                      \
      dst[n][k] = *reinterpret_cast<const bf16x8*>((char*)SB(b, h) + lds_byte(wc * 32 + n * 16 + fr, k * 32 + fq * 8))
#define MMA(ai, bj, At_, Bt_)                                                                        \
  do {                                                                                               \
    __builtin_amdgcn_s_setprio(1);                                                                   \
    for (int m = 0; m < 4; ++m)                                                                      \
      for (int n = 0; n < 2; ++n)                                                                    \
        for (int k = 0; k < 2; ++k)                                                                  \
          acc[ai][bj][m][n] = __builtin_amdgcn_mfma_f32_16x16x32_bf16(At_[m][k], Bt_[n][k], acc[ai][bj][m][n], 0, 0, 0); \
    __builtin_amdgcn_s_setprio(0);                                                                   \
  } while (0)
#define WAIT_V(n) asm volatile("s_waitcnt vmcnt(" #n ")" ::: "memory")
#define WAIT_L(n) asm volatile("s_waitcnt lgkmcnt(" #n ")" ::: "memory")
#define BAR __builtin_amdgcn_s_barrier()
#define SCHED __builtin_amdgcn_sched_barrier(0)

  int brow = 0, bcol = 0;
  if ((int)blockIdx.x < nwg) {
    gemm_tile_coords(blockIdx.x, nwg, nN, brow, bcol);
    STB(SB(0, 0), bcol, 0); STA(SA(0, 0), brow, 0);
    STB(SB(0, 1), bcol + HALF, 0); STA(SA(0, 1), brow + AH, 0);
  }
#pragma unroll 1
  for (int L = blockIdx.x; L < nwg; L += gridDim.x) {
    f32x4 acc[2][2][4][2];
#pragma unroll
    for (int a = 0; a < 2; ++a)
#pragma unroll
      for (int b = 0; b < 2; ++b)
#pragma unroll
        for (int m = 0; m < 4; ++m)
#pragma unroll
          for (int n = 0; n < 2; ++n) acc[a][b][m][n] = f32x4{0.f, 0.f, 0.f, 0.f};
    bf16x8 At[4][2], B0[2][2], B1[2][2];

    if (wr == 1) BAR;
    WAIT_V(0); BAR;
    STB(SB(1, 0), bcol, 1); STA(SA(1, 0), brow, 1); STB(SB(1, 1), bcol + HALF, 1);
    WAIT_V(6); BAR;
#pragma unroll 1
    for (int t = 0; t < nt - 2; t += 2) {
      LDB(B0, 0, 0); SCHED; LDA(At, 0, 0); STA(SA(1, 1), brow + AH, t + 1);
      WAIT_L(8); BAR; WAIT_L(0); MMA(0, 0, At, B0); BAR; SCHED;
      LDB(B1, 0, 1); STB(SB(0, 0), bcol, t + 2);
      BAR; WAIT_L(0); MMA(0, 1, At, B1); BAR;
      LDA(At, 0, 1); STA(SA(0, 0), brow, t + 2);
      BAR; WAIT_L(0); MMA(1, 0, At, B0); BAR; SCHED;
      STB(SB(0, 1), bcol + HALF, t + 2);
      WAIT_V(6); BAR; MMA(1, 1, At, B1); BAR;
      LDB(B0, 1, 0); SCHED; LDA(At, 1, 0); STA(SA(0, 1), brow + AH, t + 2);
      WAIT_L(8); BAR; WAIT_L(0); MMA(0, 0, At, B0); BAR; SCHED;
      LDB(B1, 1, 1); STB(SB(1, 0), bcol, t + 3);
      BAR; WAIT_L(0); MMA(0, 1, At, B1); BAR;
      LDA(At, 1, 1); STA(SA(1, 0), brow, t + 3);
      BAR; WAIT_L(0); MMA(1, 0, At, B0); BAR; SCHED;
      STB(SB(1, 1), bcol + HALF, t + 3);
      WAIT_V(6); BAR; MMA(1, 1, At, B1); BAR;
    }
    {
      LDB(B0, 0, 0); LDA(At, 0, 0); STA(SA(1, 1), brow + AH, nt - 1);
      BAR; WAIT_L(0); MMA(0, 0, At, B0); BAR;
      LDB(B1, 0, 1); BAR; WAIT_L(0); MMA(0, 1, At, B1); BAR;
      LDA(At, 0, 1); WAIT_V(4); BAR; WAIT_L(0); MMA(1, 0, At, B0); MMA(1, 1, At, B1); BAR;
    }
    {
      LDB(B0, 1, 0); LDA(At, 1, 0); WAIT_V(2); BAR; WAIT_L(0); MMA(0, 0, At, B0); BAR;
      LDB(B1, 1, 1); WAIT_V(0); BAR; WAIT_L(0); MMA(0, 1, At, B1); BAR;
      LDA(At, 1, 1); BAR; WAIT_L(0); MMA(1, 0, At, B0); MMA(1, 1, At, B1); BAR;
    }
    if (wr == 0) BAR;
    const int crow0 = brow, ccol0 = bcol;
    if (L + (int)gridDim.x < nwg) {
      gemm_tile_coords(L + gridDim.x, nwg, nN, brow, bcol);
      STB(SB(0, 0), bcol, 0); STA(SA(0, 0), brow, 0);
      STB(SB(0, 1), bcol + HALF, 0); STA(SA(0, 1), brow + AH, 0);
    }
    {
      const int t2 = opaque_tid();
      const int wid2 = t2 >> 6, ln2 = t2 & 63, wr2 = wid2 >> 2, wc2 = wid2 & 3, fr2 = ln2 & 15, fq2 = ln2 >> 4;
      if (EPI == EPI_GU || EPI == EPI_IN1) {
        float* sS = reinterpret_cast<float*>(smem + 131072) + 768;
        if (t2 < 256) {
          const float4 q4 = reinterpret_cast<const float4*>(d.ss)[crow0 + t2];
          sS[t2] = rsqrtf((q4.x + q4.y + q4.z + q4.w) * (1.f / 1024.f) + EPS_);
        }
        __syncthreads();
        const float* sp = sS + (wr2 * 4 + fq2) * 32;
#pragma unroll
        for (int ai = 0; ai < 2; ++ai)
#pragma unroll
          for (int m = 0; m < 4; ++m) {
            const float4 s4 = *reinterpret_cast<const float4*>(sp + ai * 16 + m * 4);
            const float sv[4] = {s4.x, s4.y, s4.z, s4.w};
#pragma unroll
            for (int j = 0; j < 4; ++j)
#pragma unroll
              for (int bj = 0; bj < 2; ++bj) { acc[ai][bj][m][0][j] *= sv[j]; acc[ai][bj][m][1][j] *= sv[j]; }
          }
      }
      if (EPI == EPI_RES) {
#pragma unroll
        for (int ai = 0; ai < 2; ++ai) {
          float2 xin[4][4][2];
#pragma unroll
          for (int m = 0; m < 4; ++m)
#pragma unroll
            for (int j = 0; j < 4; ++j)
#pragma unroll
              for (int bj = 0; bj < 2; ++bj) {
                const size_t idx = (size_t)(crow0 + ai * HALF + wr2 * 64 + m * 16 + fq2 * 4 + j) * 1024 + ccol0 + bj * HALF + wc2 * 32 + 2 * fr2;
                if (d.res16) {
                  const u32 w = *reinterpret_cast<const u32*>(d.res16 + idx);
                  xin[m][j][bj] = make_float2(bflo(w), bfhi(w));
                } else {
                  xin[m][j][bj] = *reinterpret_cast<const float2*>(d.res + idx);
                }
              }
          asm volatile("" ::: "memory");
#pragma unroll
          for (int m = 0; m < 4; ++m)
#pragma unroll
            for (int j = 0; j < 4; ++j) {
              const int row = crow0 + ai * HALF + wr2 * 64 + m * 16 + fq2 * 4 + j;
              float sq = 0.f;
#pragma unroll
              for (int bj = 0; bj < 2; ++bj) {
                const size_t idx = (size_t)row * 1024 + ccol0 + bj * HALF + wc2 * 32 + 2 * fr2;
                float x0 = xin[m][j][bj].x + acc[ai][bj][m][0][j], x1 = xin[m][j][bj].y + acc[ai][bj][m][1][j];
                if (d.dst) *reinterpret_cast<float2*>(d.dst + idx) = make_float2(x0, x1);
                if (d.xb) {
                  const u32 w = pack2(x0, x1);
                  *reinterpret_cast<u32*>(d.xb + idx) = w;
                  x0 = bflo(w); x1 = bfhi(w);
                }
                sq += x0 * x0 + x1 * x1;
              }
              if (d.ss) {
                sq += __shfl_xor(sq, 1); sq += __shfl_xor(sq, 2); sq += __shfl_xor(sq, 4); sq += __shfl_xor(sq, 8);
                if (fr2 == 0) reinterpret_cast<float*>(smem + 131072)[wc2 * 256 + (row - crow0)] = sq;
              }
            }
        }
        if (d.ss) {
          __syncthreads();
          if (t2 < 256) {
            const float* e = reinterpret_cast<const float*>(smem + 131072) + t2;
            d.ss[(size_t)(crow0 + t2) * 4 + (ccol0 >> 8)] = e[0] + e[256] + e[512] + e[768];
          }
        }
      } else if (EPI == EPI_IN1) {
        char* R = p.ws + O_R;
        float* ex = reinterpret_cast<float*>(smem + 131072);
        const int mt = crow0 >> 8;
        const int tk0 = crow0 + (wr2 * 4 + fq2) * 32;
        const bool has_x = (ccol0 + 256 > 1024) && (ccol0 < 2560);
        if (has_x) {
          if (wr2 == 0 && fq2 == 3) {
#pragma unroll
            for (int bj = 0; bj < 2; ++bj)
#pragma unroll
              for (int nb = 0; nb < 2; ++nb)
#pragma unroll
                for (int r = 0; r < 3; ++r) ex[((((bj * 4 + wc2) * 16 + fr2) * 2 + nb) * 3) + r] = acc[1][bj][3][nb][1 + r];
          }
          __syncthreads();
        }
        const bool tile_head = (wr2 == 0 && fq2 == 0);
#pragma unroll
        for (int bj = 0; bj < 2; ++bj) {
          const int c0 = ccol0 + bj * HALF + wc2 * 32 + 2 * fr2;
          if (c0 < 1024) {
            u16* zp = reinterpret_cast<u16*>(R + R_Z) + (size_t)tk0 * 1024 + c0;
#pragma unroll
            for (int ai = 0; ai < 2; ++ai)
#pragma unroll
              for (int m = 0; m < 4; ++m)
#pragma unroll
                for (int j = 0; j < 4; ++j)
                  *reinterpret_cast<u32*>(zp + (size_t)(ai * 16 + m * 4 + j) * 1024) = pack2(acc[ai][bj][m][0][j], acc[ai][bj][m][1][j]);
          } else if (c0 < 2560) {
            const int xcn = c0 - 1024;
            const float* cw = reinterpret_cast<const float*>(p.in[17]);
            const float* cbias = reinterpret_cast<const float*>(p.in[18]);
            float ov[2][32];
#pragma unroll
            for (int nb = 0; nb < 2; ++nb) {
              const int ch = xcn + nb;
              const float b = cbias[ch], w0 = cw[ch], w1 = cw[1536 + ch], w2 = cw[2 * 1536 + ch], w3 = cw[3 * 1536 + ch];
              float g3 = __shfl(acc[1][bj][3][nb][1], (ln2 - 16) & 63);
              float g2 = __shfl(acc[1][bj][3][nb][2], (ln2 - 16) & 63);
              float g1 = __shfl(acc[1][bj][3][nb][3], (ln2 - 16) & 63);
              if (wr2 == 1 && fq2 == 0) {
                const float* e = ex + ((((bj * 4 + wc2) * 16 + fr2) * 2 + nb) * 3);
                g3 = e[0]; g2 = e[1]; g1 = e[2];
              }
              if (tile_head) {
                float* hx = reinterpret_cast<float*>(R + R_HEADX) + ((size_t)mt * 3) * 1536 + ch;
                hx[0] = acc[0][bj][0][nb][0]; hx[1536] = acc[0][bj][0][nb][1]; hx[2 * 1536] = acc[0][bj][0][nb][2];
              }
              if (wr2 == 1 && fq2 == 3) {
                float* tx = reinterpret_cast<float*>(R + R_TAILX) + ((size_t)mt * 3) * 1536 + ch;
                tx[0] = acc[1][bj][3][nb][1]; tx[1536] = acc[1][bj][3][nb][2]; tx[2 * 1536] = acc[1][bj][3][nb][3];
              }
#pragma unroll
              for (int ai = 0; ai < 2; ++ai)
#pragma unroll
                for (int m = 0; m < 4; ++m)
#pragma unroll
                  for (int j = 0; j < 4; ++j) {
                    const float g = acc[ai][bj][m][nb][j];
                    ov[nb][ai * 16 + m * 4 + j] = siluf(b + w0 * g3 + w1 * g2 + w2 * g1 + w3 * g);
                    g3 = g2; g2 = g1; g1 = g;
                  }
            }
            u16* xp = reinterpret_cast<u16*>(R + R_XBCC) + (size_t)tk0 * 1536 + xcn;
#pragma unroll
            for (int k = 0; k < 32; ++k)
              if (!(tile_head && k < 3)) *reinterpret_cast<u32*>(xp + (size_t)k * 1536) = pack2(ov[0][k], ov[1][k]);
          } else if (c0 < 2576) {
            const float* dt_bias = reinterpret_cast<const float*>(p.in[19]);
            const float b0 = dt_bias[c0 - 2560], b1 = dt_bias[c0 - 2559];
            float* dp = reinterpret_cast<float*>(R + R_DT) + (size_t)tk0 * 16 + (c0 - 2560);
#pragma unroll
            for (int ai = 0; ai < 2; ++ai)
#pragma unroll
              for (int m = 0; m < 4; ++m)
#pragma unroll
                for (int j = 0; j < 4; ++j) {
                  const float u0 = acc[ai][bj][m][0][j] + b0, u1 = acc[ai][bj][m][1][j] + b1;
                  float* q = dp + (size_t)(ai * 16 + m * 4 + j) * 16;
                  q[0] = fmaxf(u0, 0.f) + LN2_ * lg2(1.f + ex2(-fabsf(u0) * LOG2E_));
                  q[1] = fmaxf(u1, 0.f) + LN2_ * lg2(1.f + ex2(-fabsf(u1) * LOG2E_));
                }
          } else if (c0 < 4112) {
            u16* qp = reinterpret_cast<u16*>(R + R_QKV1) + (size_t)tk0 * 1536 + (c0 - 2576);
#pragma unroll
            for (int ai = 0; ai < 2; ++ai)
#pragma unroll
              for (int m = 0; m < 4; ++m)
#pragma unroll
                for (int j = 0; j < 4; ++j)
                  *reinterpret_cast<u32*>(qp + (size_t)(ai * 16 + m * 4 + j) * 1536) = pack2(acc[ai][bj][m][0][j], acc[ai][bj][m][1][j]);
          }
        }
      } else if (EPI == EPI_GU) {
        char* R = p.ws + O_R;
        const float* cw = d.res;
        const float* cbias = d.dst;
        float* ex = reinterpret_cast<float*>(smem + 131072);
        const int mt = crow0 >> 8;
        const int tk0 = crow0 + (wr2 * 4 + fq2) * 32;
        const int ch0 = (ccol0 >> 8) * 128 + (wc2 * 16 + fr2) * 2;
        if (wr2 == 0 && fq2 == 3) {
#pragma unroll
          for (int bj = 0; bj < 2; ++bj) {
            ex[((bj * 4 + wc2) * 16 + fr2) * 2] = acc[1][bj][3][0][2];
            ex[((bj * 4 + wc2) * 16 + fr2) * 2 + 1] = acc[1][bj][3][0][3];
          }
        }
        __syncthreads();
        const bool tile_head = (wr2 == 0 && fq2 == 0);
        u16* actp = reinterpret_cast<u16*>(R + R_GU) + (size_t)tk0 * 2816 + ch0;
        float a_out[2][32];
#pragma unroll
        for (int bj = 0; bj < 2; ++bj) {
          const int ch = ch0 + bj;
          const float b = cbias[ch], w0 = cw[ch], w1 = cw[2816 + ch], w2 = cw[2 * 2816 + ch];
          float gm1 = __shfl(acc[1][bj][3][0][3], (ln2 - 16) & 63);
          float gm2 = __shfl(acc[1][bj][3][0][2], (ln2 - 16) & 63);
          if (wr2 == 1 && fq2 == 0) {
            gm2 = ex[((bj * 4 + wc2) * 16 + fr2) * 2];
            gm1 = ex[((bj * 4 + wc2) * 16 + fr2) * 2 + 1];
          }
          if (tile_head) {
            float* hg = reinterpret_cast<float*>(R + R_HEADG) + ((size_t)mt * 2) * 2816 + ch;
            float* hu = reinterpret_cast<float*>(R + R_HEADU) + ((size_t)mt * 2) * 2816 + ch;
            hg[0] = acc[0][bj][0][0][0]; hg[2816] = acc[0][bj][0][0][1];
            hu[0] = acc[0][bj][0][1][0]; hu[2816] = acc[0][bj][0][1][1];
          }
          if (wr2 == 1 && fq2 == 3) {
            float* tg = reinterpret_cast<float*>(R + R_TAILG) + ((size_t)mt * 2) * 2816 + ch;
            tg[0] = acc[1][bj][3][0][2]; tg[2816] = acc[1][bj][3][0][3];
          }
#pragma unroll
          for (int ai = 0; ai < 2; ++ai)
#pragma unroll
            for (int m = 0; m < 4; ++m)
#pragma unroll
              for (int j = 0; j < 4; ++j) {
                const float g = acc[ai][bj][m][0][j];
                const float v = b + w0 * gm2 + w1 * gm1 + w2 * g;
                a_out[bj][ai * 16 + m * 4 + j] = siluf(v) * acc[ai][bj][m][1][j];
                gm2 = gm1; gm1 = g;
              }
        }
#pragma unroll
        for (int k = 0; k < 32; ++k)
          if (!(tile_head && k < 2))
            *reinterpret_cast<u32*>(actp + (size_t)k * 2816) = pack2(a_out[0][k], a_out[1][k]);
      } else {
#pragma unroll
        for (int ai = 0; ai < 2; ++ai) {
          float2 csr[4][4];
          float rsr[4][4];
#pragma unroll
          for (int m = 0; m < 4; ++m)
#pragma unroll
            for (int j = 0; j < 4; ++j) {
              const int row = crow0 + ai * HALF + wr2 * 64 + m * 16 + fq2 * 4 + j;
              csr[m][j] = make_float2(1.f, 0.f);
              rsr[m][j] = 1.f;
              if (EPI == EPI_IN0) csr[m][j] = reinterpret_cast<const float2*>(p.ws + O_ROPE)[(size_t)row * 32 + (wc2 & 1) * 16 + fr2];
              if (EPI == EPI_UQ) csr[m][j] = reinterpret_cast<const float2*>(p.ws + O_ROPE)[(size_t)row * 32 + 2 * fr2];
              if (EPI == EPI_UQ || EPI == EPI_UKV) rsr[m][j] = rs[row];
            }
          asm volatile("" ::: "memory");
#pragma unroll
          for (int bj = 0; bj < 2; ++bj)
#pragma unroll
            for (int m = 0; m < 4; ++m)
#pragma unroll
              for (int j = 0; j < 4; ++j)
                gemm_store<EPI>(p, d, crow0 + ai * HALF + wr2 * 64 + m * 16 + fq2 * 4 + j, ccol0 + bj * HALF + wc2 * 32, fr2,
                                acc[ai][bj][m][0][j], acc[ai][bj][m][1][j], csr[m][j], rsr[m][j]);
        }
      }
    }
  }
#undef SA
#undef SB
#undef STAGE
#undef STA
#undef STB
#undef LDA
#undef LDB
#undef MMA
}

template <int MODE>
DI void attn_phase(const Params& p, char* smem) {
  constexpr int DK = (MODE == 0) ? 96 : 64;
  constexpr int NKS = DK / 16;
  constexpr int KSTR = (DK + 8) * 2;
  constexpr int NKCH = DK / 8;
  constexpr int VSTR = 136;
  constexpr int STG = 64 * KSTR + 64 * VSTR;
  char* R = p.ws + O_R;
  int tid_ = threadIdx.x;
  asm volatile("" : "+v"(tid_));
  const int tid = tid_, lane = tid & 63, wave = tid >> 6, l31 = lane & 31, hh = lane >> 5;
  const int nitems = (MODE == 2) ? 1024 : 1536;
  for (int L = blockIdx.x; L < nitems; L += gridDim.x) {
    int b, head, qb, dil = 1, rr = 0, grp = 0, jh = 0;
    if (MODE == 0) {
      const int rnd = L / (int)gridDim.x, pos = L % (int)gridDim.x;
      const bool whole = (nitems % (int)gridDim.x) == 0;
      const int idx = (whole && (rnd & 1)) ? (rnd * (int)gridDim.x + (int)gridDim.x - 1 - pos) : L;
      qb = 15 - idx / 96; const int bh = idx % 96; b = bh / 12; head = bh % 12;
    }
    else if (MODE == 2) { qb = 15 - L / 64; const int bh = L % 64; b = bh >> 3; head = bh & 7; }
    else {
      b = L / 192; const int r1 = L % 192; grp = r1 >> 6; const int r2 = r1 & 63; jh = r2 >> 4; const int u = r2 & 15;
      dil = (grp == 0) ? 1 : (grp == 1 ? 4 : 16);
      rr = u % dil; qb = u / dil; head = grp * 4 + jh;
    }
    const size_t tokb = (size_t)b * SEQ_;
    const u16 *Qb, *Kb, *Vb, *K2b = nullptr;
    size_t qstr, kstr;
    if (MODE == 0) {
      Qb = reinterpret_cast<const u16*>(R + R_QMLA) + tokb * 1152 + head * 96; qstr = 1152;
      Kb = reinterpret_cast<const u16*>(R + R_KMLA) + tokb * 768 + head * 64; kstr = 768;
      Vb = reinterpret_cast<const u16*>(R + R_VMLA) + tokb * 768 + head * 64;
      K2b = reinterpret_cast<const u16*>(R + R_KPE) + tokb * 32;
    } else if (MODE == 1) {
      Qb = reinterpret_cast<const u16*>(R + R_QKV0) + (tokb + rr) * 2304 + head * 64; qstr = (size_t)dil * 2304;
      Kb = Qb + 768; Vb = Qb + 1536; kstr = qstr;
    } else {
      Qb = reinterpret_cast<const u16*>(R + R_QKV1) + tokb * 1536 + head * 64; qstr = 1536;
      Kb = Qb + 512; Vb = Qb + 1024; kstr = 1536;
    }
    int first, step, count;
    if (MODE == 0) { first = 0; step = 64; count = 4 * qb + 4; }
    else if (MODE == 1) { first = (qb == 0) ? 0 : 256 * qb - 128; step = 64; count = (qb == 0) ? 4 : 6; }
    else { first = 64 * (4 * qb + 3); step = -64; count = 4 * qb + 4; }
    const int iq0 = 256 * qb + 32 * wave;
    const int iq = iq0 + l31;

    bf16x8 qf[NKS];
    {
      const u16* qp = Qb + (size_t)iq * qstr + hh * 8;
#pragma unroll
      for (int ks = 0; ks < NKS; ++ks) qf[ks] = *reinterpret_cast<const bf16x8*>(qp + ks * 16);
    }
    f32x16 o[2];
#pragma unroll
    for (int db = 0; db < 2; ++db)
#pragma unroll
      for (int i = 0; i < 16; ++i) o[db][i] = 0.f;
    float m_run = -1e30f, l_run = 0.f, Rsum = 0.f;

    uint4 kreg0, kreg1 = make_uint4(0, 0, 0, 0), vreg0 = make_uint4(0, 0, 0, 0), vreg1 = make_uint4(0, 0, 0, 0);
#define ATT_GLOAD(ik0_)                                                                               \
  do {                                                                                               \
    {                                                                                                \
      const int row_ = tid / NKCH, kc_ = tid % NKCH;                                                 \
      const size_t ik_ = (size_t)((ik0_) + row_);                                                    \
      const u16* s_;                                                                                 \
      if (MODE == 0) s_ = (kc_ < 8) ? (Kb + ik_ * 768 + kc_ * 8) : (K2b + ik_ * 32 + (kc_ - 8) * 8);  \
      else s_ = Kb + ik_ * kstr + kc_ * 8;                                                           \
      kreg0 = *reinterpret_cast<const uint4*>(s_);                                                   \
    }                                                                                                \
    if (MODE == 0 && tid < 256) {                                                                    \
      const int c_ = tid + 512, row_ = c_ / NKCH, kc_ = c_ % NKCH;                                   \
      const size_t ik_ = (size_t)((ik0_) + row_);                                                    \
      const u16* s_ = (kc_ < 8) ? (Kb + ik_ * 768 + kc_ * 8) : (K2b + ik_ * 32 + (kc_ - 8) * 8);      \
      kreg1 = *reinterpret_cast<const uint4*>(s_);                                                   \
    }                                                                                                \
    if (tid < 256) {                                                                                 \
      const int kg_ = tid & 31, dg_ = tid >> 5;                                                      \
      vreg0 = *reinterpret_cast<const uint4*>(Vb + (size_t)((ik0_) + 2 * kg_) * kstr + dg_ * 8);     \
      vreg1 = *reinterpret_cast<const uint4*>(Vb + (size_t)((ik0_) + 2 * kg_ + 1) * kstr + dg_ * 8); \
    }                                                                                                \
  } while (0)
#define ATT_VW(w_, av_, cv_)                                                                          \
  do {                                                                                               \
    *reinterpret_cast<u32*>(VtW + (dg_ * 8 + 2 * (w_)) * VSTR + kg_ * 4) = ((av_) & 0xffffu) | ((cv_) << 16);          \
    *reinterpret_cast<u32*>(VtW + (dg_ * 8 + 2 * (w_) + 1) * VSTR + kg_ * 4) = ((av_) >> 16) | ((cv_) & 0xffff0000u);  \
  } while (0)
#define ATT_SWRITE()                                                                                  \
  do {                                                                                               \
    *reinterpret_cast<uint4*>(KsW + (tid / NKCH) * KSTR + (tid % NKCH) * 16) = kreg0;                 \
    if (MODE == 0 && tid < 256)                                                                      \
      *reinterpret_cast<uint4*>(KsW + ((tid + 512) / NKCH) * KSTR + ((tid + 512) % NKCH) * 16) = kreg1; \
    if (tid < 256) {                                                                                 \
      const int kg_ = tid & 31, dg_ = tid >> 5;                                                      \
      ATT_VW(0, vreg0.x, vreg1.x); ATT_VW(1, vreg0.y, vreg1.y);                                      \
      ATT_VW(2, vreg0.z, vreg1.z); ATT_VW(3, vreg0.w, vreg1.w);                                      \
    }                                                                                                \
  } while (0)
    volatile int* flg = reinterpret_cast<volatile int*>(smem + 49152);
    ATT_GLOAD(first);
    __syncthreads();
    {
      char* KsW = smem; char* VtW = smem + 64 * KSTR;
      ATT_SWRITE();
      if (MODE == 2 && tid == 0) { flg[0] = 1; flg[1] = 1; }
    }
    __syncthreads();
    for (int j = 0; j < count; ++j) {
      const int ik0 = first + j * step;
      const char* Ks = smem + (j & 1) * STG;
      const char* Vt = Ks + 64 * KSTR;
      if (MODE == 2) {
        if (j > 0 && flg[(j - 1) % 3] != 0) break;
        if (tid == 0) flg[(j + 1) % 3] = 1;
      }
      if (j + 1 < count) ATT_GLOAD(ik0 + step);

      bool skip;
      if (MODE == 0) skip = ik0 > iq0 + 31;
      else if (MODE == 1) skip = (ik0 > iq0 + 31) || (ik0 + 63 < iq0 - 128);
      else skip = ik0 >= iq0 + 31;
      if (skip) {
        if (MODE == 2) flg[j % 3] = 0;
      } else {
      f32x16 st[2];
      bf16x8 kf[2][NKS];
#pragma unroll
      for (int kb = 0; kb < 2; ++kb) {
        const char* kp = Ks + (kb * 32 + l31) * KSTR + hh * 16;
#pragma unroll
        for (int ks = 0; ks < NKS; ++ks) kf[kb][ks] = *reinterpret_cast<const bf16x8*>(kp + ks * 32);
      }
      __builtin_amdgcn_sched_barrier(0);
#pragma unroll
      for (int kb = 0; kb < 2; ++kb)
#pragma unroll
        for (int i = 0; i < 16; ++i) st[kb][i] = 0.f;
#pragma unroll
      for (int ks = 0; ks < NKS; ++ks) {
        st[0] = MFMA32(kf[0][ks], qf[ks], st[0]);
        st[1] = MFMA32(kf[1][ks], qf[ks], st[1]);
      }
      __builtin_amdgcn_sched_barrier(0);
      uint4 vf[4][2];
#pragma unroll
      for (int s4 = 0; s4 < 4; ++s4)
#pragma unroll
        for (int db = 0; db < 2; ++db) {
          const char* vp = Vt + (db * 32 + l31) * VSTR + s4 * 32 + hh * 8;
          const uint2 lo = *reinterpret_cast<const uint2*>(vp);
          const uint2 hi = *reinterpret_cast<const uint2*>(vp + 16);
          vf[s4][db] = make_uint4(lo.x, lo.y, hi.x, hi.y);
        }
      __builtin_amdgcn_sched_barrier(0);

      if (MODE != 2) {
        const float sc = ((MODE == 0) ? 0.10206207261596577f : 0.125f) * LOG2E_;
        const bool need_mask = (MODE == 1) || (__builtin_amdgcn_readfirstlane((int)(ik0 + 63 > iq0)) != 0);
        if (need_mask) {
#pragma unroll
          for (int kb = 0; kb < 2; ++kb)
#pragma unroll
            for (int i = 0; i < 16; ++i) {
              const int ik = ik0 + kb * 32 + crow(i, hh);
              bool valid = ik <= iq;
              if (MODE == 1) valid = valid && (iq - ik <= 128);
              st[kb][i] = valid ? st[kb][i] : -1e30f;
            }
          asm volatile("" ::: "memory");
        }
        float mxr = -1e30f;
#pragma unroll
        for (int kb = 0; kb < 2; ++kb)
#pragma unroll
          for (int i = 0; i < 16; ++i) mxr = fmaxf(mxr, st[kb][i]);
        float mx = fmaxf(m_run, (mxr > -1e29f) ? mxr * sc : -1e30f);
        mx = fmaxf(mx, __shfl_xor(mx, 32));
        const float alpha = ex2(m_run - mx);
        m_run = mx;
        float ps = 0.f;
#pragma unroll
        for (int kb = 0; kb < 2; ++kb)
#pragma unroll
          for (int i = 0; i < 16; ++i) {
            const float v = st[kb][i];
            const float pv = (MODE == 0 || v > -1e29f) ? ex2(fmaf(v, sc, -mx)) : 0.f;
            st[kb][i] = pv;
            ps += pv;
          }
        l_run = l_run * alpha + ps;
        if (!__all(alpha == 1.f)) {
#pragma unroll
          for (int db = 0; db < 2; ++db)
#pragma unroll
            for (int i = 0; i < 16; ++i) o[db][i] *= alpha;
        }
      } else {
        float own[8], par[8];
        float lsv[2][16];
#pragma unroll
        for (int kb = 0; kb < 2; ++kb)
#pragma unroll
          for (int g = 0; g < 4; ++g) {
            float gs = 0.f;
#pragma unroll
            for (int e = 0; e < 4; ++e) {
              const int i = g * 4 + e;
              const int ik = ik0 + kb * 32 + crow(i, hh);
              const float z = st[kb][i] * 0.125f;
              const float sp = fmaxf(z, 0.f) + LN2_ * lg2(1.f + ex2(-fabsf(z) * LOG2E_));
              const bool valid = ik < iq;
              const float ls = valid ? -sp : 0.f;
              lsv[kb][i] = ls;
              st[kb][i] = valid ? (z + ls) : -1e30f;
              gs += ls;
            }
            own[kb * 4 + g] = gs;
          }
#pragma unroll
        for (int a = 0; a < 8; ++a) par[a] = __shfl_xor(own[a], 32);
        float run = 0.f, sg[8];
#pragma unroll
        for (int a = 7; a >= 0; --a) {
          const float g_odd = hh ? own[a] : par[a];
          const float g_even = hh ? par[a] : own[a];
          const float sg_odd = run; run += g_odd;
          const float sg_even = run; run += g_even;
          sg[a] = hh ? sg_odd : sg_even;
        }
#pragma unroll
        for (int kb = 0; kb < 2; ++kb)
#pragma unroll
          for (int g = 0; g < 4; ++g) {
            float aft = Rsum + sg[kb * 4 + g];
#pragma unroll
            for (int e = 3; e >= 0; --e) {
              const int i = g * 4 + e;
              const float u = st[kb][i];
              st[kb][i] = (u > -1e29f) ? ex2((u + aft) * LOG2E_) : 0.f;
              aft += lsv[kb][i];
            }
          }
        Rsum += run;
      }

#pragma unroll
      for (int s4 = 0; s4 < 4; ++s4) {
        const int kb = s4 >> 1, base = (s4 & 1) * 8;
        uint4 pw;
        pw.x = pack2(st[kb][base + 0], st[kb][base + 1]);
        pw.y = pack2(st[kb][base + 2], st[kb][base + 3]);
        pw.z = pack2(st[kb][base + 4], st[kb][base + 5]);
        pw.w = pack2(st[kb][base + 6], st[kb][base + 7]);
        const bf16x8 pf = as_bf16x8(pw);
#pragma unroll
        for (int db = 0; db < 2; ++db) o[db] = MFMA32(as_bf16x8(vf[s4][db]), pf, o[db]);
      }
      if (MODE == 2) {
        if (!(Rsum < -104.f)) flg[j % 3] = 0;
      }
      }
      if (j + 1 < count) {
        char* KsW = smem + ((j + 1) & 1) * STG; char* VtW = KsW + 64 * KSTR;
        ATT_SWRITE();
      }
      __syncthreads();
    }

    float inv = 1.f;
    if (MODE != 2) {
      const float lt = l_run + __shfl_xor(l_run, 32);
      inv = 1.f / lt;
      if (MODE == 1 && hh == 0) {
        float* lse = reinterpret_cast<float*>(R + R_LSE);
        const size_t tok = tokb + (size_t)iq * dil + rr;
        lse[((size_t)grp * T_ + tok) * 4 + jh] = LN2_ * (m_run + lg2(lt));
      }
    }
    if (MODE == 1) {
      u16* dst = reinterpret_cast<u16*>(R + R_DSWO);
      const size_t tok = tokb + (size_t)iq * dil + rr;
      u16* dp = dst + (((size_t)grp * T_ + tok) * 4 + jh) * 64;
#pragma unroll
      for (int db = 0; db < 2; ++db)
#pragma unroll
        for (int g = 0; g < 4; ++g) {
          const int d0 = db * 32 + 8 * g + 4 * hh;
          uint2 w;
          w.x = pack2(o[db][4 * g] * inv, o[db][4 * g + 1] * inv);
          w.y = pack2(o[db][4 * g + 2] * inv, o[db][4 * g + 3] * inv);
          *reinterpret_cast<uint2*>(dp + d0) = w;
        }
    } else {
      u16* dp;
      if (MODE == 0) dp = reinterpret_cast<u16*>(p.ws + O_HN) + (tokb + iq) * 1024 + 256 + head * 64;
      else dp = reinterpret_cast<u16*>(R + R_YCAT1) + (tokb + iq) * 1536 + 1024 + head * 64;
#pragma unroll
      for (int db = 0; db < 2; ++db)
#pragma unroll
        for (int g = 0; g < 4; ++g) {
          const int d0 = db * 32 + 8 * g + 4 * hh;
          uint2 w;
          w.x = pack2(o[db][4 * g] * inv, o[db][4 * g + 1] * inv);
          w.y = pack2(o[db][4 * g + 2] * inv, o[db][4 * g + 3] * inv);
          *reinterpret_cast<uint2*>(dp + d0) = w;
        }
    }
  }
}

DI void ssd_scan_dt(const float* dtc, int head, float Aneg, int lane, float* csS, float* dtS) {
  const float d0 = dtc[(unsigned)(2 * lane * 16 + head)], d1 = dtc[(unsigned)((2 * lane + 1) * 16 + head)];
  const float a0 = d0 * Aneg, a1 = d1 * Aneg;
  float s = a0 + a1;
#pragma unroll
  for (int off = 1; off < 64; off <<= 1) {
    const float v = __shfl_up(s, off);
    if (lane >= off) s += v;
  }
  csS[2 * lane] = s - a1; csS[2 * lane + 1] = s;
  dtS[2 * lane] = d0; dtS[2 * lane + 1] = d1;
}

DI void ssd_stage_half(const uint4 (&br)[4], const uint4 (&xr)[2], int h2, int kc, int rb, int kx, int rx, float cs_end,
                       const float* csS, const float* dtS, char* BTs, char* xT) {
  float w0, w1, w2, w3;
  {
    const int s = 64 * h2 + rb * 4;
    w0 = dtS[s] * ex2((cs_end - csS[s]) * LOG2E_);
    w1 = dtS[s + 1] * ex2((cs_end - csS[s + 1]) * LOG2E_);
    w2 = dtS[s + 2] * ex2((cs_end - csS[s + 2]) * LOG2E_);
    w3 = dtS[s + 3] * ex2((cs_end - csS[s + 3]) * LOG2E_);
  }
  char* bt = BTs + (kc * 8) * 272 + (64 * h2 + rb * 4) * 2;
#define SSD_BT(e_, c_, f_)                                                                              \
  do {                                                                                                 \
    uint2 w_;                                                                                          \
    w_.x = pack2(f_(br[0].c_) * w0, f_(br[1].c_) * w1);                                                 \
    w_.y = pack2(f_(br[2].c_) * w2, f_(br[3].c_) * w3);                                                 \
    *reinterpret_cast<uint2*>(bt + (e_) * 272) = w_;                                                   \
  } while (0)
  SSD_BT(0, x, bflo); SSD_BT(1, x, bfhi); SSD_BT(2, y, bflo); SSD_BT(3, y, bfhi);
  SSD_BT(4, z, bflo); SSD_BT(5, z, bfhi); SSD_BT(6, w, bflo); SSD_BT(7, w, bfhi);
#undef SSD_BT
  char* xt = xT + (kx * 8) * 272 + (64 * h2 + rx * 2) * 2;
#define SSD_XT(w_, c_)                                                                                  \
  do {                                                                                                 \
    *reinterpret_cast<u32*>(xt + (2 * (w_)) * 272) = (xr[0].c_ & 0xffffu) | (xr[1].c_ << 16);           \
    *reinterpret_cast<u32*>(xt + (2 * (w_) + 1) * 272) = (xr[0].c_ >> 16) | (xr[1].c_ & 0xffff0000u);   \
  } while (0)
  SSD_XT(0, x); SSD_XT(1, y); SSD_XT(2, z); SSD_XT(3, w);
#undef SSD_XT
}

DI void ssd_states_phase(const Params& p, char* smem) {
  char* R = p.ws + O_R;
  const u16* xc = reinterpret_cast<const u16*>(R + R_XBCC);
  const float* dtb = reinterpret_cast<const float*>(R + R_DT);
  u16* stb = reinterpret_cast<u16*>(p.ws + O_HN);
  float* dec = reinterpret_cast<float*>(R + R_DEC);
  const int tid_ = opaque_tid();
  const int sub = tid_ >> 8;
  smem += sub * 53248;
  const int tid = tid_ & 255, lane = tid & 63, wave = tid >> 6, l31 = lane & 31, hh = lane >> 5;
  char* BTs = smem;
  char* xT = smem + 34816;
  float* csS = reinterpret_cast<float*>(smem + 52224);
  float* dtS = csS + 128;
#pragma unroll 1
  for (int base = blockIdx.x * 2; base < 4096; base += gridDim.x * 2) {
    const int item = base + sub, head = item & 15, grp = head >> 3;
    const size_t t0 = (size_t)(item >> 4) * 128;
    const u16* xcb = xc + (size_t)(unsigned)__builtin_amdgcn_readfirstlane((int)(t0 * 1536));
    const float Aneg = -__expf(reinterpret_cast<const float*>(p.in[20])[head]);
    if (wave == 0) ssd_scan_dt(dtb + (size_t)(unsigned)__builtin_amdgcn_readfirstlane((int)(t0 * 16)), head, Aneg, lane, csS, dtS);
    const int kc = tid & 15, rb = tid >> 4, kx = tid & 7, rx = tid >> 3;
    uint4 br0[4], br1[4], xr0[2], xr1[2];
#pragma unroll
    for (int i = 0; i < 4; ++i) {
      br0[i] = *reinterpret_cast<const uint4*>(xcb + (unsigned)((rb * 4 + i) * 1536 + 1024 + grp * 128 + kc * 8));
      br1[i] = *reinterpret_cast<const uint4*>(xcb + (unsigned)((64 + rb * 4 + i) * 1536 + 1024 + grp * 128 + kc * 8));
    }
#pragma unroll
    for (int i = 0; i < 2; ++i) {
      xr0[i] = *reinterpret_cast<const uint4*>(xcb + (unsigned)((rx * 2 + i) * 1536 + head * 64 + kx * 8));
      xr1[i] = *reinterpret_cast<const uint4*>(xcb + (unsigned)((64 + rx * 2 + i) * 1536 + head * 64 + kx * 8));
    }
    __syncthreads();
    const float cs_end = csS[127];
    ssd_stage_half(br0, xr0, 0, kc, rb, kx, rx, cs_end, csS, dtS, BTs, xT);
    ssd_stage_half(br1, xr1, 1, kc, rb, kx, rx, cs_end, csS, dtS, BTs, xT);
    __syncthreads();
    f32x16 hacc[2];
    {
      bf16x8 bfr[8], af0[8], af1[8];
      const char* bp = BTs + (32 * wave + l31) * 272 + hh * 16;
      const char* ap = xT + l31 * 272 + hh * 16;
#pragma unroll
      for (int ks = 0; ks < 8; ++ks) {
        bfr[ks] = *reinterpret_cast<const bf16x8*>(bp + ks * 32);
        af0[ks] = *reinterpret_cast<const bf16x8*>(ap + ks * 32);
        af1[ks] = *reinterpret_cast<const bf16x8*>(ap + 32 * 272 + ks * 32);
      }
      __builtin_amdgcn_sched_barrier(0);
#pragma unroll
      for (int pb = 0; pb < 2; ++pb)
#pragma unroll
        for (int i = 0; i < 16; ++i) hacc[pb][i] = 0.f;
#pragma unroll
      for (int ks = 0; ks < 8; ++ks) {
        hacc[0] = MFMA32(af0[ks], bfr[ks], hacc[0]);
        hacc[1] = MFMA32(af1[ks], bfr[ks], hacc[1]);
      }
      __builtin_amdgcn_sched_barrier(0);
    }
    u16* sp = stb + (size_t)item * 8192 + 32 * wave + l31;
#pragma unroll
    for (int pb = 0; pb < 2; ++pb)
#pragma unroll
      for (int i = 0; i < 16; ++i) sp[(pb * 32 + crow(i, hh)) * 128] = f2bf(hacc[pb][i]);
    if (tid == 0) dec[item] = ex2(cs_end * LOG2E_);
    __syncthreads();
  }
}

DI void ssd_scan_phase(const Params& p) {
  u32* stb = reinterpret_cast<u32*>(p.ws + O_HN);
  const float* dec = reinterpret_cast<const float*>(p.ws + O_R + R_DEC);
  const size_t gn = GN_;
  for (size_t u = GT_; u < (size_t)8 * 16 * 4096; u += gn) {
    const int bh = (int)(u >> 12), b = bh >> 4, h = bh & 15, pn2 = (int)u & 4095;
    u32* base = stb + ((size_t)(b * 32) * 16 + h) * 4096 + pn2;
    const float* dbase = dec + (size_t)(b * 32) * 16 + h;
    u32 v[32];
    float d[32];
#pragma unroll
    for (int c = 0; c < 32; ++c) { v[c] = base[(size_t)c * 16 * 4096]; d[c] = dbase[c * 16]; }
    asm volatile("" ::: "memory");
    float r0 = 0.f, r1 = 0.f;
#pragma unroll
    for (int c = 0; c < 32; ++c) {
      base[(size_t)c * 16 * 4096] = pack2(r0, r1);
      r0 = r0 * d[c] + bflo(v[c]);
      r1 = r1 * d[c] + bfhi(v[c]);
    }
  }
}

DI void ssd_out_phase(const Params& p, char* smem) {
  char* R = p.ws + O_R;
  const u16* xc = reinterpret_cast<const u16*>(R + R_XBCC);
  const float* dtb = reinterpret_cast<const float*>(R + R_DT);
  const u16* stb = reinterpret_cast<const u16*>(p.ws + O_HN);
  u16* yb = reinterpret_cast<u16*>(R + R_YCAT1);
  const int tid_ = opaque_tid();
  const int sub = tid_ >> 8;
  smem += sub * 45056;
  const int tid = tid_ & 255, lane = tid & 63, wave = tid >> 6, l31 = lane & 31, hh = lane >> 5;
  char* Bs = smem;
  char* xT = smem + 17408;
  char* Hs = smem + 26624;
  float* csS = reinterpret_cast<float*>(smem + 44032);
  float* dtS = csS + 128;
#pragma unroll 1
  for (int base = blockIdx.x * 2; base < 4096; base += gridDim.x * 2) {
    const int item = base + sub, head = item & 15, grp = head >> 3;
    const size_t t0 = (size_t)(item >> 4) * 128;
    const u16* xcb = xc + (size_t)(unsigned)__builtin_amdgcn_readfirstlane((int)(t0 * 1536));
    const float Aneg = -__expf(reinterpret_cast<const float*>(p.in[20])[head]);
    const float Dsk = reinterpret_cast<const float*>(p.in[21])[head];
    if (wave == 0) ssd_scan_dt(dtb + (size_t)(unsigned)__builtin_amdgcn_readfirstlane((int)(t0 * 16)), head, Aneg, lane, csS, dtS);
    const int lq = 32 * wave + l31;
    bf16x8 cf[8];
    {
      const u16* cp = xcb + (unsigned)(lq * 1536 + 1280 + grp * 128 + hh * 8);
#pragma unroll
      for (int ks = 0; ks < 8; ++ks) cf[ks] = *reinterpret_cast<const bf16x8*>(cp + ks * 16);
    }
    {
      const u16* hsrc = stb + (size_t)(unsigned)__builtin_amdgcn_readfirstlane(item * 8192);
#pragma unroll
      for (int i = 0; i < 4; ++i) {
        const int c = tid + 256 * i, row = c >> 4, kc = c & 15;
        *reinterpret_cast<uint4*>(Hs + row * 272 + kc * 16) = *reinterpret_cast<const uint4*>(hsrc + (unsigned)(row * 128 + kc * 8));
      }
    }
    __syncthreads();
    const float cs_l = csS[lq];
    f32x16 o[2];
    {
      bf16x8 h0[8], h1[8];
      const char* hp = Hs + l31 * 272 + hh * 16;
#pragma unroll
      for (int ks = 0; ks < 8; ++ks) {
        h0[ks] = *reinterpret_cast<const bf16x8*>(hp + ks * 32);
        h1[ks] = *reinterpret_cast<const bf16x8*>(hp + 32 * 272 + ks * 32);
      }
      __builtin_amdgcn_sched_barrier(0);
#pragma unroll
      for (int db = 0; db < 2; ++db)
#pragma unroll
        for (int i = 0; i < 16; ++i) o[db][i] = 0.f;
#pragma unroll
      for (int ks = 0; ks < 8; ++ks) {
        o[0] = MFMA32(h0[ks], cf[ks], o[0]);
        o[1] = MFMA32(h1[ks], cf[ks], o[1]);
      }
      __builtin_amdgcn_sched_barrier(0);
    }
    {
      const float el = ex2(cs_l * LOG2E_);
#pragma unroll
      for (int db = 0; db < 2; ++db)
#pragma unroll
        for (int i = 0; i < 16; ++i) o[db][i] *= el;
    }
#pragma unroll 1
    for (int j = 0; j < 2; ++j) {
      {
        const int kc = tid & 15, rb = tid >> 4;
        const u16* bsrc = xcb + (unsigned)((64 * j + rb * 4) * 1536 + 1024 + grp * 128 + kc * 8);
        const uint4 br0 = *reinterpret_cast<const uint4*>(bsrc);
        const uint4 br1 = *reinterpret_cast<const uint4*>(bsrc + 1536);
        const uint4 br2 = *reinterpret_cast<const uint4*>(bsrc + 2 * 1536);
        const uint4 br3 = *reinterpret_cast<const uint4*>(bsrc + 3 * 1536);
        const int kx = tid & 7, rx = tid >> 3;
        const u16* xsrc = xcb + (unsigned)((64 * j + rx * 2) * 1536 + head * 64 + kx * 8);
        const uint4 xr0 = *reinterpret_cast<const uint4*>(xsrc);
        const uint4 xr1 = *reinterpret_cast<const uint4*>(xsrc + 1536);
        if (j > 0) __syncthreads();
        char* bd = Bs + (rb * 4) * 272 + kc * 16;
        *reinterpret_cast<uint4*>(bd) = br0;
        *reinterpret_cast<uint4*>(bd + 272) = br1;
        *reinterpret_cast<uint4*>(bd + 2 * 272) = br2;
        *reinterpret_cast<uint4*>(bd + 3 * 272) = br3;
        char* xt = xT + (kx * 8) * 144 + rx * 4;
#define SSD_XT(w_, c_)                                                                                  \
  do {                                                                                                 \
    *reinterpret_cast<u32*>(xt + (2 * (w_)) * 144) = (xr0.c_ & 0xffffu) | (xr1.c_ << 16);               \
    *reinterpret_cast<u32*>(xt + (2 * (w_) + 1) * 144) = (xr0.c_ >> 16) | (xr1.c_ & 0xffff0000u);       \
  } while (0)
        SSD_XT(0, x); SSD_XT(1, y); SSD_XT(2, z); SSD_XT(3, w);
#undef SSD_XT
      }
      __syncthreads();
      if (64 * j <= 32 * wave + 31) {
        bf16x8 kf0[8], kf1[8];
        {
          const char* kp = Bs + l31 * 272 + hh * 16;
#pragma unroll
          for (int ks = 0; ks < 8; ++ks) {
            kf0[ks] = *reinterpret_cast<const bf16x8*>(kp + ks * 32);
            kf1[ks] = *reinterpret_cast<const bf16x8*>(kp + 32 * 272 + ks * 32);
          }
        }
        __builtin_amdgcn_sched_barrier(0);
        f32x16 st2[2];
#pragma unroll
        for (int kb = 0; kb < 2; ++kb)
#pragma unroll
          for (int i = 0; i < 16; ++i) st2[kb][i] = 0.f;
#pragma unroll
        for (int ks = 0; ks < 8; ++ks) {
          st2[0] = MFMA32(kf0[ks], cf[ks], st2[0]);
          st2[1] = MFMA32(kf1[ks], cf[ks], st2[1]);
        }
        __builtin_amdgcn_sched_barrier(0);
        uint4 vf[4][2];
#pragma unroll
        for (int s4 = 0; s4 < 4; ++s4)
#pragma unroll
          for (int db = 0; db < 2; ++db) {
            const char* vp = xT + (db * 32 + l31) * 144 + s4 * 32 + hh * 8;
            const uint2 lo = *reinterpret_cast<const uint2*>(vp);
            const uint2 hi = *reinterpret_cast<const uint2*>(vp + 16);
            vf[s4][db] = make_uint4(lo.x, lo.y, hi.x, hi.y);
          }
        __builtin_amdgcn_sched_barrier(0);
#pragma unroll
        for (int kb = 0; kb < 2; ++kb) {
#pragma unroll
          for (int g = 0; g < 4; ++g) {
            const int sb = 64 * j + kb * 32 + 8 * g + 4 * hh;
            const float4 c4 = *reinterpret_cast<const float4*>(csS + sb);
            const float4 d4 = *reinterpret_cast<const float4*>(dtS + sb);
            const float cv[4] = {c4.x, c4.y, c4.z, c4.w};
            const float dv[4] = {d4.x, d4.y, d4.z, d4.w};
#pragma unroll
            for (int e = 0; e < 4; ++e) {
              const int s = sb + e;
              const float v = st2[kb][4 * g + e] * ex2((cs_l - cv[e]) * LOG2E_) * dv[e];
              st2[kb][4 * g + e] = (s <= lq) ? v : 0.f;
            }
          }
#pragma unroll
          for (int s2 = 0; s2 < 2; ++s2) {
            const int s4 = kb * 2 + s2, bse = s2 * 8;
            uint4 pw;
            pw.x = pack2(st2[kb][bse + 0], st2[kb][bse + 1]);
            pw.y = pack2(st2[kb][bse + 2], st2[kb][bse + 3]);
            pw.z = pack2(st2[kb][bse + 4], st2[kb][bse + 5]);
            pw.w = pack2(st2[kb][bse + 6], st2[kb][bse + 7]);
            const bf16x8 pf = as_bf16x8(pw);
#pragma unroll
            for (int db = 0; db < 2; ++db) o[db] = MFMA32(as_bf16x8(vf[s4][db]), pf, o[db]);
          }
        }
      }
    }
    {
      u16* ybb = yb + (size_t)(unsigned)__builtin_amdgcn_readfirstlane((int)(t0 * 1536));
#pragma unroll
      for (int db = 0; db < 2; ++db)
#pragma unroll
        for (int g = 0; g < 4; ++g) {
          const int p0 = db * 32 + 8 * g + 4 * hh;
          const uint2 xv = *reinterpret_cast<const uint2*>(xcb + (unsigned)(lq * 1536 + head * 64 + p0));
          uint2 w;
          w.x = pack2(o[db][4 * g] + Dsk * bflo(xv.x), o[db][4 * g + 1] + Dsk * bfhi(xv.x));
          w.y = pack2(o[db][4 * g + 2] + Dsk * bflo(xv.y), o[db][4 * g + 3] + Dsk * bfhi(xv.y));
          *reinterpret_cast<uint2*>(ybb + (unsigned)(lq * 1536 + head * 64 + p0)) = w;
        }
    }
    __syncthreads();
  }
}

DI void merge_dsw_and_kpe(const Params& p, size_t gtid, size_t gthreads) {
  char* R = p.ws + O_R;
  const u16* dsw = reinterpret_cast<const u16*>(R + R_DSWO);
  const float* lse = reinterpret_cast<const float*>(R + R_LSE);
  u16* yc = reinterpret_cast<u16*>(p.ws + O_HN);
  const size_t n1 = (size_t)T_ * 32;
  for (size_t it = gtid; it < n1; it += gthreads) {
    const size_t tok = it >> 5;
    const int j = (int)(it >> 3) & 3, dq = (int)it & 7;
    const float l0 = lse[(0 * (size_t)T_ + tok) * 4 + j], l1 = lse[(1 * (size_t)T_ + tok) * 4 + j], l2 = lse[(2 * (size_t)T_ + tok) * 4 + j];
    float a[8], b[8], c[8];
    unpack8(*reinterpret_cast<const uint4*>(dsw + ((0 * (size_t)T_ + tok) * 4 + j) * 64 + dq * 8), a);
    unpack8(*reinterpret_cast<const uint4*>(dsw + ((1 * (size_t)T_ + tok) * 4 + j) * 64 + dq * 8), b);
    unpack8(*reinterpret_cast<const uint4*>(dsw + ((2 * (size_t)T_ + tok) * 4 + j) * 64 + dq * 8), c);
    const float mx = fmaxf(l0, fmaxf(l1, l2));
    const float e0 = __expf(l0 - mx), e1 = __expf(l1 - mx), e2 = __expf(l2 - mx);
    const float inv = 1.f / (e0 + e1 + e2);
    const float w0 = e0 * inv, w1 = e1 * inv, w2 = e2 * inv;
    float r[8];
#pragma unroll
    for (int e = 0; e < 8; ++e) r[e] = w0 * a[e] + w1 * b[e] + w2 * c[e];
    uint4 o;
    o.x = pack2(r[0], r[1]); o.y = pack2(r[2], r[3]); o.z = pack2(r[4], r[5]); o.w = pack2(r[6], r[7]);
    *reinterpret_cast<uint4*>(yc + tok * 1024 + j * 64 + dq * 8) = o;
  }
  const u16* cm = reinterpret_cast<const u16*>(R + R_CMLA);
  u16* kpe = reinterpret_cast<u16*>(R + R_KPE);
  const float2* rope = reinterpret_cast<const float2*>(p.ws + O_ROPE);
  const size_t n2 = (size_t)T_ * 16;
  for (size_t it = gtid; it < n2; it += gthreads) {
    const size_t tok = it >> 4;
    const int j = (int)it & 15;
    const float x1 = __uint_as_float((u32)cm[tok * 416 + 384 + j] << 16);
    const float x2 = __uint_as_float((u32)cm[tok * 416 + 384 + 16 + j] << 16);
    const float2 cs = rope[tok * 32 + 2 * j];
    kpe[tok * 32 + j] = f2bf(x1 * cs.x - x2 * cs.y);
    kpe[tok * 32 + 16 + j] = f2bf(x2 * cs.x + x1 * cs.y);
  }
}

DI void mla_row_scales(const Params& p) {
  char* R = p.ws + O_R;
  const u16* cm = reinterpret_cast<const u16*>(R + R_CMLA);
  float* rsq = reinterpret_cast<float*>(R + R_RSQ);
  float* rskv = reinterpret_cast<float*>(R + R_RSKV);
  const int ot = opaque_tid();
  const int lane = ot & 63;
  const int gw = blockIdx.x * (NTHR / 64) + (ot >> 6);
  const int nw = gridDim.x * (NTHR / 64);
  for (int t = gw; t < T_; t += nw) {
    const uint2 a = *reinterpret_cast<const uint2*>(cm + (size_t)t * 416 + lane * 4);
    const u32 b = *reinterpret_cast<const u32*>(cm + (size_t)t * 416 + 256 + lane * 2);
    float sq = bflo(a.x) * bflo(a.x) + bfhi(a.x) * bfhi(a.x) + bflo(a.y) * bflo(a.y) + bfhi(a.y) * bfhi(a.y);
    float sk = bflo(b) * bflo(b) + bfhi(b) * bfhi(b);
    sq = wave_sum(sq);
    sk = wave_sum(sk);
    if (lane == 0) {
      rsq[t] = rsqrtf(sq * (1.f / 256.f) + EPS_);
      rskv[t] = rsqrtf(sk * (1.f / 128.f) + EPS_);
    }
  }
}

DI void ffn_fixup(const Params& p, const float* __restrict__ cw, const float* __restrict__ cb, size_t gtid, size_t gthreads) {
  char* R = p.ws + O_R;
  const float* hg = reinterpret_cast<const float*>(R + R_HEADG);
  const float* hu = reinterpret_cast<const float*>(R + R_HEADU);
  const float* tg = reinterpret_cast<const float*>(R + R_TAILG);
  u16* act = reinterpret_cast<u16*>(R + R_GU);
  for (size_t it = gtid; it < 128ull * 2816; it += gthreads) {
    const int mt = (int)(it / 2816), ch = (int)(it % 2816);
    float t2 = 0.f, t1 = 0.f;
    if ((mt & 15) != 0) { t2 = tg[((size_t)(mt - 1) * 2) * 2816 + ch]; t1 = tg[((size_t)(mt - 1) * 2 + 1) * 2816 + ch]; }
    const float g0 = hg[((size_t)mt * 2) * 2816 + ch], g1 = hg[((size_t)mt * 2 + 1) * 2816 + ch];
    const float u0 = hu[((size_t)mt * 2) * 2816 + ch], u1 = hu[((size_t)mt * 2 + 1) * 2816 + ch];
    const float b = cb[ch], w0 = cw[ch], w1 = cw[2816 + ch], w2 = cw[2 * 2816 + ch];
    act[((size_t)mt * 256) * 2816 + ch] = f2bf(siluf(b + w0 * t2 + w1 * t1 + w2 * g0) * u0);
    act[((size_t)mt * 256 + 1) * 2816 + ch] = f2bf(siluf(b + w0 * t1 + w1 * g0 + w2 * g1) * u1);
  }
}

DI void ssm_fixup(const Params& p, size_t gtid, size_t gthreads) {
  char* R = p.ws + O_R;
  const float* hx = reinterpret_cast<const float*>(R + R_HEADX);
  const float* tx = reinterpret_cast<const float*>(R + R_TAILX);
  u16* xo = reinterpret_cast<u16*>(R + R_XBCC);
  const float* cw = reinterpret_cast<const float*>(p.in[17]);
  const float* cb = reinterpret_cast<const float*>(p.in[18]);
  for (size_t it = gtid; it < 128ull * 1536; it += gthreads) {
    const int mt = (int)(it / 1536), ch = (int)(it % 1536);
    float t3 = 0.f, t2 = 0.f, t1 = 0.f;
    if ((mt & 15) != 0) {
      const float* t = tx + ((size_t)(mt - 1) * 3) * 1536 + ch;
      t3 = t[0]; t2 = t[1536]; t1 = t[2 * 1536];
    }
    const float* h = hx + ((size_t)mt * 3) * 1536 + ch;
    const float g0 = h[0], g1 = h[1536], g2 = h[2 * 1536];
    const float b = cb[ch], w0 = cw[ch], w1 = cw[1536 + ch], w2 = cw[2 * 1536 + ch], w3 = cw[3 * 1536 + ch];
    u16* o = xo + ((size_t)mt * 256) * 1536 + ch;
    o[0] = f2bf(siluf(b + w0 * t3 + w1 * t2 + w2 * t1 + w3 * g0));
    o[1536] = f2bf(siluf(b + w0 * t2 + w1 * t1 + w2 * g0 + w3 * g1));
    o[2 * 1536] = f2bf(siluf(b + w0 * t1 + w1 * g0 + w2 * g1 + w3 * g2));
  }
}

DI void ssm_gate_norm(const Params& p) {
  char* R = p.ws + O_R;
  u16* yb = reinterpret_cast<u16*>(R + R_YCAT1);
  const u16* zb = reinterpret_cast<const u16*>(R + R_Z);
  const float* gn = reinterpret_cast<const float*>(p.in[22]);
  const int ot = opaque_tid();
  const int lane = ot & 63;
  const int gw = blockIdx.x * (NTHR / 64) + (ot >> 6);
  const int nw = gridDim.x * (NTHR / 64);
  constexpr int U = 4;
  for (int it0 = gw; it0 < T_ * 2; it0 += nw * U) {
    uint4 yv[U], zv[U];
#pragma unroll
    for (int u = 0; u < U; ++u) {
      const int it = (it0 + u * nw < T_ * 2) ? it0 + u * nw : it0;
      const size_t t = it >> 1;
      const int g = it & 1;
      yv[u] = *reinterpret_cast<const uint4*>(yb + t * 1536 + g * 512 + lane * 8);
      zv[u] = *reinterpret_cast<const uint4*>(zb + t * 1024 + g * 512 + lane * 8);
    }
    asm volatile("" ::: "memory");
#pragma unroll
    for (int u = 0; u < U; ++u) {
      const int it = it0 + u * nw;
      const size_t t = it >> 1;
      const int g = it & 1;
      float y[8], z[8];
      unpack8(yv[u], y);
      unpack8(zv[u], z);
      float ss = 0.f;
#pragma unroll
      for (int e = 0; e < 8; ++e) { y[e] *= siluf(z[e]); ss += y[e] * y[e]; }
      ss = wave_sum(ss);
      const float sc = rsqrtf(ss * (1.f / 512.f) + EPS_);
      const float* gp = gn + g * 512 + lane * 8;
      uint4 o;
      o.x = pack2(y[0] * sc * gp[0], y[1] * sc * gp[1]); o.y = pack2(y[2] * sc * gp[2], y[3] * sc * gp[3]);
      o.z = pack2(y[4] * sc * gp[4], y[5] * sc * gp[5]); o.w = pack2(y[6] * sc * gp[6], y[7] * sc * gp[7]);
      if (it < T_ * 2) *reinterpret_cast<uint4*>(yb + t * 1536 + g * 512 + lane * 8) = o;
    }
  }
}

DI void grid_barrier(unsigned* ctr, unsigned& epoch) {
  asm volatile("s_waitcnt vmcnt(0)" ::: "memory");
  __syncthreads();
  epoch += 1;
  if (threadIdx.x == 0) {
    __builtin_amdgcn_fence(__ATOMIC_RELEASE, "agent");
    asm volatile("s_waitcnt vmcnt(0)" ::: "memory");
    __hip_atomic_fetch_add(ctr, 1u, __ATOMIC_RELAXED, __HIP_MEMORY_SCOPE_AGENT);
    const unsigned target = epoch * gridDim.x;
    while (__hip_atomic_load(ctr, __ATOMIC_RELAXED, __HIP_MEMORY_SCOPE_AGENT) < target) __builtin_amdgcn_s_sleep(1);
    __builtin_amdgcn_fence(__ATOMIC_ACQUIRE, "agent");
    asm volatile("s_waitcnt vmcnt(0)" ::: "memory");
  }
  __syncthreads();
}

__global__ void __launch_bounds__(NTHR, 2) fwd_megakernel(Params p) {
  extern __shared__ __attribute__((aligned(16))) char smem[];
  cg::grid_group grid = cg::this_grid();
  unsigned* bar = reinterpret_cast<unsigned*>(p.ws + WS_BAR);
  unsigned epoch = 0;
  float* ssq = reinterpret_cast<float*>(p.ws + WS_SS);
  u16* xb1 = reinterpret_cast<u16*>(p.out);
  char* ws = p.ws;
  char* R = ws + O_R;
  auto F = [&](int i) { return reinterpret_cast<const float*>(p.in[i]); };
  auto W16 = [&](size_t off) { return reinterpret_cast<u16*>(ws + off); };
  u16* hn = W16(O_HN);

#pragma unroll 1
  for (int job = 0; job < 12; ++job) {
    const float* W; u16* Wt; int K, N, Npad, cmode = 0; const float* gain = nullptr;
    switch (job) {
      case 0: W = F(3); Wt = W16(O_WIN0); K = 1024; N = 2720; Npad = 2816; cmode = 1; break;
      case 1: W = F(5); Wt = W16(O_WUQ); K = 256; N = 1152; Npad = 1280; cmode = 2; gain = F(4); break;
      case 2: W = F(7); Wt = W16(O_WUKV); K = 128; N = 1536; Npad = 1536; gain = F(6); break;
      case 3: W = F(8); Wt = W16(O_WOUT0); K = 1024; N = 1024; Npad = 1024; break;
      case 4: cvt_weight_gu(F(10), F(11), W16(O_WGU0), F(9), GT_, GN_); continue;
      case 5: cvt_weight_gu(F(25), F(26), W16(O_WGU1), F(24), GT_, GN_); continue;
      case 6: W = F(14); Wt = W16(O_WDN0); K = 2816; N = 1024; Npad = 1024; break;
      case 7: W = F(16); Wt = W16(O_WIN1); K = 1024; N = 4112; Npad = 4352; gain = F(15); break;
      case 8: W = F(23); Wt = W16(O_WOUT1); K = 1536; N = 1024; Npad = 1024; break;
      case 9: continue;
      case 10: continue;
      default: W = F(29); Wt = W16(O_WDN1); K = 2816; N = 1024; Npad = 1024; break;
    }
    cvt_weight(W, Wt, K, N, Npad, cmode, gain, GT_, GN_);
  }
  {
    float2* rope = reinterpret_cast<float2*>(ws + O_ROPE);
    const int* pos = reinterpret_cast<const int*>(p.in[1]);
    const size_t gn = GN_;
    for (size_t it = GT_; it < (size_t)T_ * 32; it += gn) {
      const int i = (int)it & 31;
      const float inv = 1.0f / powf(10000.f, (float)i * (2.0f / 64.f));
      const float ang = (float)pos[it >> 5] * inv;
      float sn, cs;
      sincosf(ang, &sn, &cs);
      rope[it] = make_float2(cs, sn);
    }
  }
  rmsnorm_rows<false>(F(0), F(2), hn);
  grid.sync();

  { GemmDesc d{hn, 1024, W16(O_WIN0), 1024, 11, nullptr, nullptr, nullptr, nullptr, nullptr}; gemm_phase<EPI_IN0>(p, d, smem); }
  grid_barrier(bar, epoch);
  mla_row_scales(p);
  attn_phase<1>(p, smem);
  grid_barrier(bar, epoch);
  merge_dsw_and_kpe(p, GT_, GN_);
  {
    const u16* cm = reinterpret_cast<const u16*>(R + R_CMLA);
    GemmDesc dq{cm, 416, W16(O_WUQ), 256, 5, nullptr, nullptr, nullptr, nullptr, nullptr};
    gemm_phase<EPI_UQ>(p, dq, smem);
    GemmDesc dk{cm + 256, 416, W16(O_WUKV), 128, 6, nullptr, nullptr, nullptr, nullptr, nullptr};
    gemm_phase<EPI_UKV>(p, dk, smem);
  }
  grid_barrier(bar, epoch);
  attn_phase<0>(p, smem);
  grid_barrier(bar, epoch);
  { GemmDesc d{hn, 1024, W16(O_WOUT0), 1024, 4, F(0), nullptr, nullptr, reinterpret_cast<u16*>(R + R_XB0), ssq}; gemm_phase<EPI_RES>(p, d, smem); }
  grid_barrier(bar, epoch);
  { GemmDesc d{reinterpret_cast<const u16*>(R + R_XB0), 1024, W16(O_WGU0), 1024, 22, F(12), const_cast<float*>(F(13)), nullptr, nullptr, ssq}; gemm_phase<EPI_GU>(p, d, smem); }
  grid_barrier(bar, epoch);
  ffn_fixup(p, F(12), F(13), GT_, GN_);
  grid_barrier(bar, epoch);
  {
    const u16* act = reinterpret_cast<const u16*>(R + R_GU);
    GemmDesc d{act, 2816, W16(O_WDN0), 2816, 4, nullptr, nullptr, reinterpret_cast<const u16*>(R + R_XB0), xb1, ssq + 4 * T_};
    gemm_phase<EPI_RES>(p, d, smem);
  }
  grid_barrier(bar, epoch);
  { GemmDesc d{xb1, 1024, W16(O_WIN1), 1024, 17, nullptr, nullptr, nullptr, nullptr, ssq + 4 * T_}; gemm_phase<EPI_IN1>(p, d, smem); }
  grid_barrier(bar, epoch);
  ssm_fixup(p, GT_, GN_);
  grid_barrier(bar, epoch);
  ssd_states_phase(p, smem);
  attn_phase<2>(p, smem);
  grid_barrier(bar, epoch);
  ssd_scan_phase(p);
  grid_barrier(bar, epoch);
  ssd_out_phase(p, smem);
  grid_barrier(bar, epoch);
  ssm_gate_norm(p);
  grid_barrier(bar, epoch);
  {
    const u16* yc1 = reinterpret_cast<const u16*>(R + R_YCAT1);
    GemmDesc d{yc1, 1536, W16(O_WOUT1), 1536, 4, nullptr, nullptr, xb1, hn, ssq + 8 * T_};
    gemm_phase<EPI_RES>(p, d, smem);
  }
  grid_barrier(bar, epoch);
  { GemmDesc d{hn, 1024, W16(O_WGU1), 1024, 22, F(27), const_cast<float*>(F(28)), nullptr, nullptr, ssq + 8 * T_}; gemm_phase<EPI_GU>(p, d, smem); }
  grid_barrier(bar, epoch);
  ffn_fixup(p, F(27), F(28), GT_, GN_);
  grid_barrier(bar, epoch);
  {
    const u16* act = reinterpret_cast<const u16*>(R + R_GU);
    GemmDesc d{act, 2816, W16(O_WDN1), 2816, 4, nullptr, p.out, hn, nullptr, nullptr};
    gemm_phase<EPI_RES>(p, d, smem);
  }
  grid_barrier(bar, epoch);
  rmsnorm_rows<true>(p.out, F(30), p.out);
}

extern "C" void kernel_launch(void* const* d_in, const int* in_sizes, int n_in, void* d_out, int out_size,
                              void* d_ws, size_t ws_size, hipStream_t stream) {
  static int grid_blocks = 0;
  if (!grid_blocks) {
    int dev = 0, cus = 0, per_cu = 0;
    hipGetDevice(&dev);
    hipDeviceGetAttribute(&cus, hipDeviceAttributeMultiprocessorCount, dev);
    hipFuncSetAttribute(reinterpret_cast<const void*>(fwd_megakernel), hipFuncAttributeMaxDynamicSharedMemorySize, SMEM_BYTES);
    hipOccupancyMaxActiveBlocksPerMultiprocessor(&per_cu, fwd_megakernel, NTHR, SMEM_BYTES);
    if (per_cu > 1) per_cu = 1;
    if (per_cu < 1) per_cu = 1;
    grid_blocks = cus * per_cu;
  }
  if (ws_size < WS_NEED) fprintf(stderr, "workspace too small: %zu < %zu\n", ws_size, (size_t)WS_NEED);
  Params p{};
  for (int i = 0; i < 31; ++i) p.in[i] = d_in[i];
  p.out = reinterpret_cast<float*>(d_out);
  p.ws = reinterpret_cast<char*>(d_ws);
  hipMemsetAsync(reinterpret_cast<char*>(d_ws) + WS_BAR, 0, 256, stream);
  void* args[] = {&p};
  hipError_t e = hipLaunchCooperativeKernel(reinterpret_cast<void*>(fwd_megakernel), dim3(grid_blocks), dim3(NTHR), args, SMEM_BYTES, stream);
  if (e != hipSuccess) fprintf(stderr, "cooperative launch failed: %s (grid %d)\n", hipGetErrorString(e), grid_blocks);
}
```
